# Optimizing an MI355X kernel written in HIP

```python
import jax, jax.numpy as jnp
from jax import lax
import numpy as np

D_MODEL = 2048
BATCH = 4
SEQ = 2048
DEPTH = 2

BRANCH_WIDTH = 1024
N_BRANCH = 3
CONV_A_WIDTH = 3
POOL_WINDOWS = (2, 4, 8, 16)
N_POOL_GROUPS = len(POOL_WINDOWS)
POOL_GROUP_WIDTH = BRANCH_WIDTH // N_POOL_GROUPS
CONV_C_WIDTH = 31
PLE_DIM = 256
RMS_EPS = 1e-6
LN_EPS = 1e-5
N_BRANCH_SLICES = 9
IN_COLS = N_BRANCH_SLICES * BRANCH_WIDTH + N_BRANCH * D_MODEL

kernel_name = "hybrid_conv_pool_conformer_gated_merge"


def rms_norm(x, g):
    xf = x.astype(jnp.float32)
    y = xf * lax.rsqrt(jnp.mean(xf * xf, axis=-1, keepdims=True) + RMS_EPS)
    return (y * g.astype(jnp.float32)).astype(x.dtype)


def layer_norm(x, g, b):
    xf = x.astype(jnp.float32)
    mu = jnp.mean(xf, axis=-1, keepdims=True)
    var = jnp.mean(jnp.square(xf - mu), axis=-1, keepdims=True)
    y = (xf - mu) * lax.rsqrt(var + LN_EPS)
    return (y * g.astype(jnp.float32) + b.astype(jnp.float32)).astype(x.dtype)


def causal_dwconv(x, w):
    k = w.shape[0]
    return lax.conv_general_dilated(
        x, w.astype(x.dtype)[:, None, :], window_strides=(1,),
        padding=[(k - 1, 0)], dimension_numbers=("NWC", "WIO", "NWC"),
        feature_group_count=x.shape[-1])


def causal_multiscale_pool(u):
    s = u.shape[1]
    uf = u.astype(jnp.float32)
    cs = jnp.cumsum(uf, axis=1)
    t = jnp.arange(1, s + 1, dtype=jnp.float32)
    outs = []
    for g, w in enumerate(POOL_WINDOWS):
        c = cs[:, :, g]
        shifted = jnp.pad(c, ((0, 0), (w, 0), (0, 0)))[:, :s]
        cnt = jnp.minimum(t, jnp.float32(w))[None, :, None]
        outs.append((c - shifted) / cnt)
    pooled = jnp.stack(outs, axis=2)
    return (pooled - uf).astype(u.dtype)


def hybrid_layer(h, p_i, norm_g, w_in, conv_a_w, pool_w, pool_scale, conv_c_w, conv_c_b,
                 ln_c_g, ln_c_b, w_branch_out, w_o, w_ple_gate, w_ple_proj):
    b, s, d = h.shape
    e = BRANCH_WIDTH
    xn = rms_norm(h, norm_g)
    proj = jnp.einsum("bsd,dc->bsc", xn, w_in)
    split_pts = [e * i for i in range(1, N_BRANCH_SLICES + 1)]
    a_in, a_b, a_c, a_z, b_in, b_z, c_val, c_gate, c_z, gates = jnp.split(proj, split_pts, axis=-1)

    y_a = a_b * causal_dwconv(a_c * a_in, conv_a_w) * jax.nn.silu(a_z)

    pooled = causal_multiscale_pool(b_in.reshape(b, s, N_POOL_GROUPS, POOL_GROUP_WIDTH))
    y_b = jnp.einsum("bsgi,gio->bsgo", pooled, pool_w).reshape(b, s, e)
    y_b = y_b * pool_scale * jax.nn.silu(b_z)

    v = c_val * jax.nn.sigmoid(c_gate)
    v = causal_dwconv(v, conv_c_w) + conv_c_b
    v = layer_norm(v, ln_c_g, ln_c_b)
    y_c = jax.nn.silu(v) * jax.nn.silu(c_z)

    branches = jnp.stack([y_a, y_b, y_c], axis=2)
    up = jnp.einsum("bsne,ned->bsnd", branches, w_branch_out)
    g = jax.nn.sigmoid(gates.reshape(b, s, N_BRANCH, d))
    merged = jnp.sum(g * up, axis=2)
    h = h + jnp.einsum("bsd,de->bse", merged, w_o)

    ple = jnp.einsum("bsp,pd->bsd", p_i, w_ple_proj)
    h = h + jax.nn.sigmoid(jnp.einsum("bsd,de->bse", h, w_ple_gate)) * ple
    return h


def setup_inputs(seed: int = 0) -> dict:
    key = jax.random.key(seed)
    ks = jax.random.split(key, 16)
    f32 = jnp.float32
    d, e = D_MODEL, BRANCH_WIDTH
    nrm = lambda k, shape, scale: jax.random.normal(k, shape, f32) * scale
    return {
        "x": nrm(ks[0], (BATCH, SEQ, d), 1.0),
        "p": nrm(ks[1], (DEPTH, BATCH, SEQ, PLE_DIM), 1.0),
        "norm_g": 1.0 + nrm(ks[2], (DEPTH, d), 0.05),
        "w_in": nrm(ks[3], (DEPTH, d, IN_COLS), d ** -0.5),
        "conv_a_w": nrm(ks[4], (DEPTH, CONV_A_WIDTH, e), CONV_A_WIDTH ** -0.5),
        "pool_w": nrm(ks[5], (DEPTH, N_POOL_GROUPS, POOL_GROUP_WIDTH, POOL_GROUP_WIDTH), POOL_GROUP_WIDTH ** -0.5),
        "pool_scale": 1.0 + nrm(ks[6], (DEPTH, e), 0.1),
        "conv_c_w": nrm(ks[7], (DEPTH, CONV_C_WIDTH, e), CONV_C_WIDTH ** -0.5),
        "conv_c_b": nrm(ks[8], (DEPTH, e), 0.02),
        "ln_c_g": 1.0 + nrm(ks[9], (DEPTH, e), 0.05),
        "ln_c_b": nrm(ks[10], (DEPTH, e), 0.02),
        "w_branch_out": nrm(ks[11], (DEPTH, N_BRANCH, e, d), e ** -0.5),
        "w_o": nrm(ks[12], (DEPTH, d, d), d ** -0.5),
        "w_ple_gate": nrm(ks[13], (DEPTH, d, d), d ** -0.5),
        "w_ple_proj": nrm(ks[14], (DEPTH, PLE_DIM, d), PLE_DIM ** -0.5),
        "final_norm_g": 1.0 + nrm(ks[15], (d,), 0.05),
    }


def reference(x, p, norm_g, w_in, conv_a_w, pool_w, pool_scale, conv_c_w, conv_c_b,
              ln_c_g, ln_c_b, w_branch_out, w_o, w_ple_gate, w_ple_proj, final_norm_g):
    h = x
    for i in range(DEPTH):
        h = hybrid_layer(h, p[i], norm_g[i], w_in[i], conv_a_w[i], pool_w[i], pool_scale[i],
                         conv_c_w[i], conv_c_b[i], ln_c_g[i], ln_c_b[i], w_branch_out[i],
                         w_o[i], w_ple_gate[i], w_ple_proj[i])
    return rms_norm(h, final_norm_g)
```

```cpp
#include <hip/hip_runtime.h>
#include <hip/hip_cooperative_groups.h>
#include <cstdio>
#include <cstdint>
#include <utility>
namespace cg = cooperative_groups;

#define LAS __attribute__((address_space(3)))
typedef unsigned short bf16_t;
typedef short bf16x8 __attribute__((ext_vector_type(8)));
typedef float f32x4 __attribute__((ext_vector_type(4)));
typedef float f32x2 __attribute__((ext_vector_type(2)));
typedef unsigned u32x4 __attribute__((ext_vector_type(4)));
typedef unsigned u32x2 __attribute__((ext_vector_type(2)));

constexpr int MTOK = 8192, DM = 2048, EW = 1024, NC = 15360, PD = 256, SEQ = 2048, DEPTH = 2;
constexpr int YW = 3 * EW;
constexpr int NCO = 9 * EW;
constexpr int OQ = 0, OAB = EW, OBIN = 2 * EW, OBZ = 3 * EW, OV = 4 * EW, OCZ = 5 * EW;
constexpr int GATE_B0 = 12 * EW;
constexpr size_t ROWB = (size_t)NCO * 2;
constexpr float RMS_EPS = 1e-6f, LN_EPS = 1e-5f;

constexpr size_t WS_SSQ = 0;
constexpr size_t WS_BAR = 128 << 10;
constexpr size_t WS_WI = 1 << 20;
constexpr size_t SZ_WI = (size_t)NC * DM * 2;
constexpr size_t WS_WB = WS_WI + 2 * SZ_WI;
constexpr size_t SZ_WB = (size_t)DM * YW * 2;
constexpr size_t WS_WO = WS_WB + 2 * SZ_WB;
constexpr size_t SZ_WO = (size_t)DM * DM * 2;
constexpr size_t WS_WG = WS_WO + 2 * SZ_WO;
constexpr size_t WS_WP = WS_WG + 2 * SZ_WO;
constexpr size_t SZ_WP = (size_t)DM * PD * 2;
constexpr size_t WS_PW = WS_WP + 2 * SZ_WP;
constexpr size_t SZ_PW = (size_t)EW * 256 * 2;
constexpr size_t WS_PB = WS_PW + 2 * SZ_PW;
constexpr size_t SZ_PB = (size_t)MTOK * PD * 2;
constexpr size_t WS_PLE = WS_PB + 2 * SZ_PB;
constexpr size_t SZ_ACT = (size_t)MTOK * DM * 2;
constexpr size_t WS_HB0 = WS_PLE + 2 * SZ_ACT;
constexpr size_t WS_HB1 = WS_HB0 + SZ_ACT;
constexpr size_t WS_MG = WS_HB1 + SZ_ACT;
constexpr size_t WS_H = WS_MG + SZ_ACT;
constexpr size_t WS_PROJ0 = WS_H + 2 * SZ_ACT;
constexpr size_t SZ_PROJ = (size_t)MTOK * ROWB;
constexpr size_t WS_PROJ = WS_H;
constexpr size_t WS_POOL = WS_PROJ0 + (size_t)MTOK * NC * 2;
static_assert(WS_PROJ + DEPTH * SZ_PROJ <= WS_POOL, "projection buffers overlap the next region");
constexpr size_t WS_Y = WS_POOL + (size_t)MTOK * EW * 2;
constexpr size_t WS_END = WS_Y + (size_t)MTOK * YW * 2;

constexpr int LDS_BYTES = 147456;

typedef __bf16 bf16x2_t __attribute__((ext_vector_type(2)));
__device__ __forceinline__ unsigned cvt_pk_bf16(float lo, float hi) { const bf16x2_t r = __builtin_convertvector((f32x2){lo, hi}, bf16x2_t); return __builtin_bit_cast(unsigned, r); }
__device__ __forceinline__ float bf_lo(unsigned u) { return __uint_as_float(u << 16); }
__device__ __forceinline__ float bf_hi(unsigned u) { return __uint_as_float(u & 0xffff0000u); }
__device__ __forceinline__ f32x2 ld2(const bf16_t* p) { const unsigned u = *(const unsigned*)p; return (f32x2){bf_lo(u), bf_hi(u)}; }
__device__ __forceinline__ f32x2 un2(unsigned u) { return (f32x2){bf_lo(u), bf_hi(u)}; }
__device__ __forceinline__ void st2(bf16_t* p, f32x2 v) { *(unsigned*)p = cvt_pk_bf16(v.x, v.y); }
__device__ __forceinline__ float sigmoid_f(float x) { return __builtin_amdgcn_rcpf(1.0f + __builtin_amdgcn_exp2f(-1.4426950409f * x)); }
__device__ __forceinline__ float silu_f(float x) { return x * sigmoid_f(x); }
__device__ __forceinline__ u32x4 pack8(f32x4 a, f32x4 b) { u32x4 w; w.x = cvt_pk_bf16(a[0], a[1]); w.y = cvt_pk_bf16(a[2], a[3]); w.z = cvt_pk_bf16(b[0], b[1]); w.w = cvt_pk_bf16(b[2], b[3]); return w; }
__device__ __forceinline__ void unpack8(u32x4 g, f32x4& a, f32x4& b) { a = (f32x4){bf_lo(g.x), bf_hi(g.x), bf_lo(g.y), bf_hi(g.y)}; b = (f32x4){bf_lo(g.z), bf_hi(g.z), bf_lo(g.w), bf_hi(g.w)}; }

__device__ __forceinline__ unsigned pk_unorm8(f32x4 v) { const unsigned b0 = (unsigned)(v[0] * 255.0f + 0.5f), b1 = (unsigned)(v[1] * 255.0f + 0.5f), b2 = (unsigned)(v[2] * 255.0f + 0.5f), b3 = (unsigned)(v[3] * 255.0f + 0.5f); return b0 | (b1 << 8) | (b2 << 16) | (b3 << 24); }
__device__ __forceinline__ f32x4 un_unorm8(unsigned w) { return (f32x4){fmaxf((float)(w & 255u), 0.5f), fmaxf((float)((w >> 8) & 255u), 0.5f), fmaxf((float)((w >> 16) & 255u), 0.5f), fmaxf((float)(w >> 24), 0.5f)}; }
namespace pg8 {
constexpr int BM = 256, BK = 64, HALF = 128, HTB = HALF * BK * 2, STAGE_BYTES = 8 * HTB, NXCD = 8, WGM = 8;
__host__ __device__ __forceinline__ int lds_byte(int r, int c) { const int st = (r >> 4) * 2 + (c >> 5), rr = r & 15, cc = c & 31, ob = rr * 64 + cc * 2; return st * 1024 + (ob ^ (((ob >> 9) & 1) << 5)); }
__host__ __device__ __forceinline__ void stage_rc(int b, int& R, int& C) { const int st = b / 1024, sb = b % 1024, swz = sb ^ (((sb >> 9) & 1) << 5); R = (st >> 1) * 16 + swz / 64; C = (st & 1) * 32 + (swz % 64) / 2; }
__host__ __device__ __forceinline__ int perm32(int rho) { const int n = rho >> 4, i = rho & 15; return 8 * (i >> 2) + 4 * n + (i & 3); }

struct Unit { int pm, pn, half; };
struct Gemm { const bf16_t* A; const bf16_t* Bt; int lda, ldb, K, nM, nN, a_pn_off, lx, lr; };

struct StaticOrder {
    int nM, nN, nwg, G, c, lx, lr;
    __device__ void init(int nM_, int nN_, int G_, int c_) { nM = nM_; nN = nN_; nwg = nM * nN; G = G_; c = c_; lx = -1; lr = 0; }
    __device__ void map(int L, Unit& u) const {
        int wgid = L; { const int q = nwg / NXCD, r = nwg % NXCD, xcd = wgid % NXCD, off = wgid / NXCD; wgid = (xcd < r ? xcd * (q + 1) : r * (q + 1) + (xcd - r) * q) + off; }
        const int nig = WGM * nN, gid = wgid / nig, fm = gid * WGM, gsz = (nM - fm) < WGM ? (nM - fm) : WGM;
        u.pm = fm + ((wgid % nig) % gsz); u.pn = (wgid % nig) / gsz; u.half = 0;
    }
    __device__ bool next(int i, Unit& u) const {
        if (lx >= 0) { const int pn = i * 8 + (lr >> 2); if (pn >= nN) return false; u.pm = 4 * lx + (lr & 3); u.pn = pn; u.half = 0; return true; }
        const long L = (long)i * G + c; if (L >= nwg) return false; map((int)L, u); return true; }
};

struct HalfNOrder : StaticOrder {
    __device__ bool next(int i, Unit& u) const {
        if (lx >= 0) { if (i > 0) return false; const int rr = lr >> 2; u.pm = 4 * lx + (lr & 3); u.pn = rr >> 1; u.half = 1 + (rr & 1); return u.pn < nN; }
        const long L = (long)i * G + c; if (L >= 2L * nwg) return false;
        const int lab = (int)(L & 7), idx = (int)(L >> 3), ppl = nM >> 3, r = idx / ppl;
        u.pm = lab * ppl + idx % ppl; u.pn = r >> 1; u.half = 1 + (r & 1); return true;
    }
};

struct IdleOrder : StaticOrder {
    static constexpr int PREV_TILES = (MTOK / 256) * (NC / 256);
    __device__ bool next(int i, Unit& u) const {
        if (lx >= 0) { if (lr < 16) return false; const int idx = i * 16 + (lr - 16); if (idx >= 4 * nN) return false; u.pm = 4 * lx + (idx & 3); u.pn = idx >> 2; u.half = 0; return true; }
        const int busy = G / 2;
        if (c < busy) return false;
        const long L = (long)i * (G - busy) + (c - busy); if (L >= nwg) return false; map((int)L, u); return true;
    }
};

template <class Epi, class Order = StaticOrder, bool HALFN = false>
__device__ __forceinline__ void gemm_phase(LAS unsigned char* lds, const Gemm g, const Epi& E) {
    int tid = threadIdx.x; asm volatile("" : "+v"(tid));
    const int wid = __builtin_amdgcn_readfirstlane(tid >> 6), lane = tid & 63, wr = wid >> 2, wc = wid & 3, fr = lane & 15, fq = lane >> 4;
    const int K = g.K, nt = K / BK;
    Order S; S.init(g.nM, g.nN, (int)gridDim.x, (int)blockIdx.x); S.lx = g.lx; S.lr = g.lr;
    unsigned voffA[2], voffB[2];
#pragma unroll
    for (int i = 0; i < 2; ++i) { int R, C; stage_rc(tid * 16 + i * 8192, R, C); const int Rb = (R & ~31) + perm32(R & 31);
        voffA[i] = (unsigned)(R * g.lda + C) * 2u; voffB[i] = (unsigned)(Rb * g.ldb + C) * 2u; }
    const size_t kstep = (size_t)(BK * 2);
    const size_t hstepA = (size_t)HALF * g.lda * 2, hstepB = (size_t)HALF * g.ldb * 2;
    const size_t tstepA = 2 * hstepA, tstepB = 2 * hstepB;
    const unsigned ldsw = (unsigned)wid * 1024u;
    const int aoff = lds_byte(wr * 64 + fr, fq * 8), boff = lds_byte(wc * 32 + fr, fq * 8);
#define PG8_SA(b, h) (((b) * 2 + (h)) * HTB)
#define PG8_SB(b, h) ((4 + (b) * 2 + (h)) * HTB)
#define PG8_STAGE(bufoff, gbase, voff) do { _Pragma("unroll") for (int _i = 0; _i < 2; ++_i) \
        __builtin_amdgcn_global_load_lds((const unsigned*)((const char*)(gbase) + (voff)[_i]), (LAS unsigned*)(lds + (bufoff) + ldsw + _i * 8192), 16, 0, 0); } while (0)
#define PG8_LDA(dst, b, h) do { _Pragma("unroll") for (int m = 0; m < 4; ++m) _Pragma("unroll") for (int k = 0; k < 2; ++k) dst[m][k] = *(const LAS bf16x8*)(lds + PG8_SA(b, h) + aoff + m * 2048 + k * 1024); } while (0)
#define PG8_LDB(dst, b, h) do { _Pragma("unroll") for (int n = 0; n < 2; ++n) _Pragma("unroll") for (int k = 0; k < 2; ++k) dst[n][k] = *(const LAS bf16x8*)(lds + PG8_SB(b, h) + boff + n * 2048 + k * 1024); } while (0)
#define PG8_MMA(ai, bj, At, Bt) do { __builtin_amdgcn_s_setprio(1); _Pragma("unroll") for (int m = 0; m < 4; ++m) _Pragma("unroll") for (int n = 0; n < 2; ++n) _Pragma("unroll") for (int k = 0; k < 2; ++k) \
        acc[ai][bj][m][n] = __builtin_amdgcn_mfma_f32_16x16x32_bf16(Bt[n][k], At[m][k], acc[ai][bj][m][n], 0, 0, 0); __builtin_amdgcn_s_setprio(0); } while (0)
#define PG8_WAIT_V(n) asm volatile("s_waitcnt vmcnt(" #n ")" ::: "memory")
#define PG8_WAIT_L(n) asm volatile("s_waitcnt lgkmcnt(" #n ")" ::: "memory")
#define PG8_BAR __builtin_amdgcn_s_barrier()
#define PG8_SCHED __builtin_amdgcn_sched_barrier(0)
    Unit cur, nxt; int ui = 0;
    if (!S.next(0, cur)) return;
    f32x4 acc[2][2][4][2];
    if constexpr (Epi::INIT) E.init(acc, cur, wr, wc, fr, fq);
    else {
#pragma unroll
    for (int a = 0; a < 2; ++a)
#pragma unroll
        for (int b = 0; b < 2; ++b)
#pragma unroll
            for (int m = 0; m < 4; ++m)
#pragma unroll
                for (int n = 0; n < 2; ++n) acc[a][b][m][n] = (f32x4){0.f, 0.f, 0.f, 0.f};
    }
    bf16x8 At[4][2], B0[2][2], B1[2][2];
    const char* cA = (const char*)g.A + (size_t)cur.pm * tstepA + (size_t)cur.pn * g.a_pn_off * 2; const char* cB = (const char*)g.Bt + (size_t)cur.pn * tstepB + (HALFN ? (size_t)(cur.half - 1) * hstepB : (size_t)0);
    PG8_STAGE(PG8_SB(0, 0), cB, voffB); PG8_STAGE(PG8_SB(0, 1), cB + hstepB, voffB); PG8_STAGE(PG8_SA(0, 0), cA, voffA); PG8_STAGE(PG8_SA(0, 1), cA + hstepA, voffA);
    if (wr == 1) PG8_BAR;
    PG8_WAIT_V(2); PG8_BAR;
    PG8_STAGE(PG8_SB(1, 0), cB + kstep, voffB); PG8_STAGE(PG8_SA(1, 0), cA + kstep, voffA); PG8_STAGE(PG8_SB(1, 1), cB + hstepB + kstep, voffB);
    PG8_WAIT_V(6); PG8_BAR;
    for (;;) {
        const bool has_next = S.next(ui + 1, nxt);
        const char* nA = has_next ? (const char*)g.A + (size_t)nxt.pm * tstepA + (size_t)nxt.pn * g.a_pn_off * 2 : cA; const char* nB = has_next ? (const char*)g.Bt + (size_t)nxt.pn * tstepB + (HALFN ? (size_t)(nxt.half - 1) * hstepB : (size_t)0) : cB;
#pragma unroll 1
        for (int t = 0; t < nt; t += 2) {
            const bool last = (t == nt - 2);
            if constexpr (Epi::SEAMS) { if (t == Epi::SEAM0 || t == Epi::SEAM1) E.seam(acc, cur, t == Epi::SEAM0 ? 0 : 1, wr, wc, fr, fq); }
            const char* a1 = cA + (size_t)(t + 1) * kstep;
            const char* a2 = last ? nA : cA + (size_t)(t + 2) * kstep; const char* b2 = last ? nB : cB + (size_t)(t + 2) * kstep;
            const char* a3 = a2 + kstep; const char* b3 = b2 + kstep;
            PG8_LDB(B0, 0, 0); if constexpr (!HALFN) PG8_LDB(B1, 0, 1); PG8_SCHED; PG8_LDA(At, 0, 0); PG8_STAGE(PG8_SA(1, 1), a1 + hstepA, voffA);
            PG8_WAIT_V(8); PG8_WAIT_L(0); PG8_BAR; PG8_MMA(0, 0, At, B0); if constexpr (!HALFN) PG8_MMA(0, 1, At, B1); PG8_BAR; PG8_SCHED;
            PG8_LDA(At, 0, 1); PG8_STAGE(PG8_SB(0, 0), b2, voffB); PG8_STAGE(PG8_SB(0, 1), b2 + hstepB, voffB); PG8_STAGE(PG8_SA(0, 0), a2, voffA);
            PG8_WAIT_V(8); PG8_WAIT_L(0); PG8_BAR; PG8_MMA(1, 0, At, B0); if constexpr (!HALFN) PG8_MMA(1, 1, At, B1); PG8_BAR; PG8_SCHED;
            PG8_LDB(B0, 1, 0); if constexpr (!HALFN) PG8_LDB(B1, 1, 1); PG8_SCHED; PG8_LDA(At, 1, 0); PG8_STAGE(PG8_SA(0, 1), a2 + hstepA, voffA);
            PG8_WAIT_V(8); PG8_WAIT_L(0); PG8_BAR; PG8_MMA(0, 0, At, B0); if constexpr (!HALFN) PG8_MMA(0, 1, At, B1); PG8_BAR; PG8_SCHED;
            PG8_LDA(At, 1, 1); PG8_STAGE(PG8_SB(1, 0), b3, voffB); PG8_STAGE(PG8_SB(1, 1), b3 + hstepB, voffB); PG8_STAGE(PG8_SA(1, 0), a3, voffA);
            PG8_WAIT_V(8); PG8_WAIT_L(0); PG8_BAR; PG8_MMA(1, 0, At, B0); if constexpr (!HALFN) PG8_MMA(1, 1, At, B1); PG8_BAR; PG8_SCHED;
        }
        if (wr == 0) PG8_BAR;
        E(acc, cur, wr, wc, fr, fq);
        if (!has_next) break;
        if constexpr (Epi::INIT) E.init(acc, nxt, wr, wc, fr, fq);
        else {
#pragma unroll
        for (int a = 0; a < 2; ++a)
#pragma unroll
            for (int b = 0; b < 2; ++b)
#pragma unroll
                for (int m = 0; m < 4; ++m)
#pragma unroll
                    for (int n = 0; n < 2; ++n) acc[a][b][m][n] = (f32x4){0.f, 0.f, 0.f, 0.f};
        }
        cur = nxt; cA = nA; cB = nB; ++ui;
        if (wr == 1) PG8_BAR;
    }
    PG8_WAIT_V(0);
    PG8_BAR;
#undef PG8_SA
#undef PG8_SB
#undef PG8_STAGE
#undef PG8_LDA
#undef PG8_LDB
#undef PG8_MMA
#undef PG8_WAIT_V
#undef PG8_WAIT_L
#undef PG8_BAR
#undef PG8_SCHED
}
}
using pg8::Unit;

#define EPI_OPAQUE asm volatile("" : "+v"(fr), "+v"(fq));
#define EPI_ROWS_BEGIN _Pragma("unroll") for (int ai = 0; ai < 2; ++ai) _Pragma("unroll") for (int m = 0; m < 4; ++m) { const int row = u.pm * 256 + ai * 128 + wr * 64 + m * 16 + fr;
#define EPI_COLS_BEGIN _Pragma("unroll") for (int bj = 0; bj < 2; ++bj) { const int col = u.pn * 256 + bj * 128 + wc * 32 + 8 * fq;
#define EPI_END }

struct EpiProj {
    static constexpr bool SEAMS = false, INIT = false; static constexpr int SEAM0 = -1, SEAM1 = -1;
    bf16_t* P; const float* ssq; int pn0;
    __device__ __forceinline__ void seam(f32x4 (&)[2][2][4][2], const Unit&, int, int, int, int, int) const {}
    template <int ACT> __device__ __forceinline__ void body(f32x4 (&acc)[2][2][4][2], const Unit& u, int wr, int wc, int fr, int fq, int obase, const float (&rsv)[2][4]) const {
        EPI_ROWS_BEGIN
            const float rs = rsv[ai][m];
#pragma unroll
            for (int bj = 0; bj < 2; ++bj) { const int col = obase + bj * 128 + wc * 32 + 8 * fq;
                f32x4 v0 = acc[ai][bj][m][0] * rs, v1 = acc[ai][bj][m][1] * rs;
                if (ACT == 1) {
#pragma unroll
                    for (int j = 0; j < 4; ++j) { v0[j] = silu_f(v0[j]); v1[j] = silu_f(v1[j]); } }
                if (ACT == 2) {
#pragma unroll
                    for (int j = 0; j < 4; ++j) { v0[j] = sigmoid_f(v0[j]); v1[j] = sigmoid_f(v1[j]); } }
                __builtin_nontemporal_store(pack8(v0, v1), (u32x4*)(P + (size_t)row * NCO + col));
            }
        EPI_END
    }
    __device__ __forceinline__ void body_gate(f32x4 (&acc)[2][2][4][2], const Unit& u, int wr, int wc, int fr, int fq, int gbase, const float (&rsv)[2][4]) const {
        EPI_ROWS_BEGIN
            const float rs = rsv[ai][m];
#pragma unroll
            for (int bj = 0; bj < 2; ++bj) { if (u.half != 0 && bj == 1) continue;
                const int gcol = gbase + (bj + (u.half == 2 ? 1 : 0)) * 128 + wc * 32 + 8 * fq;
                f32x4 v0 = acc[ai][bj][m][0] * rs, v1 = acc[ai][bj][m][1] * rs;
#pragma unroll
                for (int j = 0; j < 4; ++j) { v0[j] = sigmoid_f(v0[j]); v1[j] = sigmoid_f(v1[j]); }
                u32x2 w; w.x = pk_unorm8(v0); w.y = pk_unorm8(v1);
                *(u32x2*)((unsigned char*)P + (size_t)row * ROWB + GATE_B0 + gcol) = w;
            }
        EPI_END
    }
    template <int ACT> __device__ __forceinline__ void body_pair(f32x4 (&acc)[2][2][4][2], const Unit& u, int wr, int wc, int fr, int fq, int obase, const float (&rsv)[2][4]) const {
        EPI_ROWS_BEGIN
            const float rs = rsv[ai][m]; const int col = obase + wc * 32 + 8 * fq;
            f32x4 a0 = acc[ai][0][m][0] * rs, a1 = acc[ai][0][m][1] * rs, b0 = acc[ai][1][m][0] * rs, b1 = acc[ai][1][m][1] * rs;
            if (ACT == 1) {
#pragma unroll
                for (int j = 0; j < 4; ++j) { b0[j] = silu_f(b0[j]); b1[j] = silu_f(b1[j]); } }
            if (ACT == 2) {
#pragma unroll
                for (int j = 0; j < 4; ++j) { b0[j] = sigmoid_f(b0[j]); b1[j] = sigmoid_f(b1[j]); } }
            __builtin_nontemporal_store(pack8(a0 * b0, a1 * b1), (u32x4*)(P + (size_t)row * NCO + col));
        EPI_END
    }
    __device__ __forceinline__ void operator()(f32x4 (&acc)[2][2][4][2], const Unit& u, int wr, int wc, int fr, int fq) const {
        EPI_OPAQUE
        float rsv[2][4];
#pragma unroll
        for (int ai = 0; ai < 2; ++ai)
#pragma unroll
            for (int m = 0; m < 4; ++m) rsv[ai][m] = ssq[u.pm * 256 + ai * 128 + wr * 64 + m * 16 + fr];
        asm volatile("" ::: "memory");
#pragma unroll
        for (int ai = 0; ai < 2; ++ai)
#pragma unroll
            for (int m = 0; m < 4; ++m) rsv[ai][m] = __builtin_amdgcn_rsqf(rsv[ai][m] * (1.0f / DM) + RMS_EPS);
        const int pn = u.pn + pn0;
        if (pn < 8) body_pair<0>(acc, u, wr, wc, fr, fq, OQ + pn * 128, rsv);
        else if (pn < 16) body_pair<1>(acc, u, wr, wc, fr, fq, OAB + (pn - 8) * 128, rsv);
        else if (pn < 20) body<0>(acc, u, wr, wc, fr, fq, OBIN + (pn - 16) * 256, rsv);
        else if (pn < 24) body<1>(acc, u, wr, wc, fr, fq, OBZ + (pn - 20) * 256, rsv);
        else if (pn < 32) body_pair<2>(acc, u, wr, wc, fr, fq, OV + (pn - 24) * 128, rsv);
        else if (pn < 36) body<1>(acc, u, wr, wc, fr, fq, OCZ + (pn - 32) * 256, rsv);
        else body_gate(acc, u, wr, wc, fr, fq, (pn - 36) * 256, rsv);
    }
};
struct EpiPlain {
    static constexpr bool SEAMS = false, INIT = false; static constexpr int SEAM0 = -1, SEAM1 = -1;
    bf16_t* O; int ldo;
    __device__ __forceinline__ void seam(f32x4 (&)[2][2][4][2], const Unit&, int, int, int, int, int) const {}
    __device__ __forceinline__ void operator()(f32x4 (&acc)[2][2][4][2], const Unit& u, int wr, int wc, int fr, int fq) const {
        EPI_OPAQUE
        EPI_ROWS_BEGIN EPI_COLS_BEGIN
            *(u32x4*)(O + (size_t)row * ldo + col) = pack8(acc[ai][bj][m][0], acc[ai][bj][m][1]);
        EPI_END EPI_END
    }
};
struct EpiPool {
    static constexpr bool SEAMS = false, INIT = false; static constexpr int SEAM0 = -1, SEAM1 = -1;
    bf16_t* Y; const float* pscale; const bf16_t* P;
    __device__ __forceinline__ void seam(f32x4 (&)[2][2][4][2], const Unit&, int, int, int, int, int) const {}
    __device__ __forceinline__ void operator()(f32x4 (&acc)[2][2][4][2], const Unit& u, int wr, int wc, int fr, int fq) const {
        EPI_OPAQUE
#pragma unroll
        for (int ai = 0; ai < 2; ++ai) {
            u32x4 zz[4][2];
#pragma unroll
            for (int m = 0; m < 4; ++m)
#pragma unroll
                for (int bj = 0; bj < 2; ++bj) { const int row = u.pm * 256 + ai * 128 + wr * 64 + m * 16 + fr, col = u.pn * 256 + bj * 128 + wc * 32 + 8 * fq;
                    zz[m][bj] = *(const u32x4*)(P + (size_t)row * NCO + OBZ + col); }
            asm volatile("" ::: "memory");
#pragma unroll
            for (int m = 0; m < 4; ++m)
#pragma unroll
                for (int bj = 0; bj < 2; ++bj) { const int row = u.pm * 256 + ai * 128 + wr * 64 + m * 16 + fr, col = u.pn * 256 + bj * 128 + wc * 32 + 8 * fq;
                    const f32x4 s0 = *(const f32x4*)(pscale + col), s1 = *(const f32x4*)(pscale + col + 4);
                    f32x4 z0, z1; unpack8(zz[m][bj], z0, z1);
                    *(u32x4*)(Y + (size_t)row * YW + EW + col) = pack8(acc[ai][bj][m][0] * s0 * z0, acc[ai][bj][m][1] * s1 * z1); }
            asm volatile("" ::: "memory");
        }
    }
};
struct EpiMerge {
    static constexpr bool SEAMS = true, INIT = false; static constexpr int SEAM0 = EW / 64, SEAM1 = 2 * EW / 64;
    const bf16_t* P; bf16_t* MG;
    __device__ __forceinline__ void seam(f32x4 (&acc)[2][2][4][2], const Unit& u, int n, int wr, int wc, int fr, int fq) const {
        EPI_OPAQUE
#pragma unroll
        for (int ai = 0; ai < 2; ++ai) {
            u32x2 ga[4][2], gb[4][2];
#pragma unroll
            for (int m = 0; m < 4; ++m)
#pragma unroll
                for (int bj = 0; bj < 2; ++bj) { const int row = u.pm * 256 + ai * 128 + wr * 64 + m * 16 + fr, col = u.pn * 256 + bj * 128 + wc * 32 + 8 * fq;
                    const unsigned char* gp = (const unsigned char*)P + (size_t)row * ROWB + GATE_B0 + n * DM + col; ga[m][bj] = *(const u32x2*)gp; gb[m][bj] = *(const u32x2*)(gp + DM); }
#pragma unroll
            for (int m = 0; m < 4; ++m)
#pragma unroll
                for (int bj = 0; bj < 2; ++bj) { const f32x4 a0 = un_unorm8(ga[m][bj].x), a1 = un_unorm8(ga[m][bj].y), b0 = un_unorm8(gb[m][bj].x), b1 = un_unorm8(gb[m][bj].y);
#pragma unroll
                    for (int j = 0; j < 4; ++j) { acc[ai][bj][m][0][j] *= a0[j] * __builtin_amdgcn_rcpf(b0[j]); acc[ai][bj][m][1][j] *= a1[j] * __builtin_amdgcn_rcpf(b1[j]); } }
            asm volatile("" ::: "memory");
        }
    }
    __device__ __forceinline__ void operator()(f32x4 (&acc)[2][2][4][2], const Unit& u, int wr, int wc, int fr, int fq) const {
        EPI_OPAQUE
#pragma unroll
        for (int ai = 0; ai < 2; ++ai) {
            u32x2 gg[4][2];
#pragma unroll
            for (int m = 0; m < 4; ++m)
#pragma unroll
                for (int bj = 0; bj < 2; ++bj) { const int row = u.pm * 256 + ai * 128 + wr * 64 + m * 16 + fr, col = u.pn * 256 + bj * 128 + wc * 32 + 8 * fq;
                    gg[m][bj] = *(const u32x2*)((const unsigned char*)P + (size_t)row * ROWB + GATE_B0 + 2 * DM + col); }
            asm volatile("" ::: "memory");
#pragma unroll
            for (int m = 0; m < 4; ++m)
#pragma unroll
                for (int bj = 0; bj < 2; ++bj) { const int row = u.pm * 256 + ai * 128 + wr * 64 + m * 16 + fr, col = u.pn * 256 + bj * 128 + wc * 32 + 8 * fq;
                    const f32x4 g0 = un_unorm8(gg[m][bj].x) * (1.0f / 255.0f), g1 = un_unorm8(gg[m][bj].y) * (1.0f / 255.0f);
                    *(u32x4*)(MG + (size_t)row * DM + col) = pack8(acc[ai][bj][m][0] * g0, acc[ai][bj][m][1] * g1); }
            asm volatile("" ::: "memory");
        }
    }
};
struct EpiWo {
    static constexpr bool SEAMS = false, INIT = true; static constexpr int SEAM0 = -1, SEAM1 = -1;
    const float* basef; const bf16_t* baseb; bf16_t* HB;
    __device__ __forceinline__ void seam(f32x4 (&)[2][2][4][2], const Unit&, int, int, int, int, int) const {}
    __device__ __forceinline__ void init(f32x4 (&acc)[2][2][4][2], const Unit& u, int wr, int wc, int fr, int fq) const {
        EPI_OPAQUE
        if (basef) {
            EPI_ROWS_BEGIN EPI_COLS_BEGIN
                const size_t off = (size_t)row * DM + col;
                acc[ai][bj][m][0] = *(const f32x4*)(basef + off); acc[ai][bj][m][1] = *(const f32x4*)(basef + off + 4);
            EPI_END EPI_END
        } else {
            EPI_ROWS_BEGIN EPI_COLS_BEGIN
                unpack8(*(const u32x4*)(baseb + (size_t)row * DM + col), acc[ai][bj][m][0], acc[ai][bj][m][1]);
            EPI_END EPI_END
        }
    }
    __device__ __forceinline__ void operator()(f32x4 (&acc)[2][2][4][2], const Unit& u, int wr, int wc, int fr, int fq) const {
        EPI_OPAQUE
        EPI_ROWS_BEGIN EPI_COLS_BEGIN
            *(u32x4*)(HB + (size_t)row * DM + col) = pack8(acc[ai][bj][m][0], acc[ai][bj][m][1]);
        EPI_END EPI_END
    }
};
struct EpiGate {
    static constexpr bool SEAMS = false, INIT = false; static constexpr int SEAM0 = -1, SEAM1 = -1;
    const bf16_t* H1; const bf16_t* PLE; bf16_t* HB; float* ssq;
    __device__ __forceinline__ void seam(f32x4 (&)[2][2][4][2], const Unit&, int, int, int, int, int) const {}
    __device__ __forceinline__ void operator()(f32x4 (&acc)[2][2][4][2], const Unit& u, int wr, int wc, int fr, int fq) const {
        EPI_OPAQUE
        const int row0 = u.pm * 256 + wr * 64 + fr, col0 = u.pn * 256 + wc * 32 + 8 * fq;
        u32x4 hA[2][2], pA[2][2];
#define GATE_LOAD(r, b) do { const int row_ = row0 + ((r) >> 2) * 128 + ((r) & 3) * 16; _Pragma("unroll") for (int bj = 0; bj < 2; ++bj) { const size_t off_ = (size_t)row_ * DM + col0 + bj * 128; \
            hA[b][bj] = *(const u32x4*)(H1 + off_); pA[b][bj] = *(const u32x4*)(PLE + off_); } } while (0)
        GATE_LOAD(0, 0);
#pragma unroll
        for (int r = 0; r < 8; ++r) {
            const int ai = r >> 2, m = r & 3, b = r & 1;
            if (r + 1 < 8) GATE_LOAD(r + 1, (r + 1) & 1);
            const int row = row0 + ai * 128 + m * 16;
            float ss = 0.f;
#pragma unroll
            for (int bj = 0; bj < 2; ++bj) {
                const size_t off = (size_t)row * DM + col0 + bj * 128;
                f32x4 p0, p1, o0, o1; unpack8(pA[b][bj], p0, p1); unpack8(hA[b][bj], o0, o1);
#pragma unroll
                for (int j = 0; j < 4; ++j) { o0[j] += sigmoid_f(acc[ai][bj][m][0][j]) * p0[j]; o1[j] += sigmoid_f(acc[ai][bj][m][1][j]) * p1[j]; }
                *(u32x4*)(HB + off) = pack8(o0, o1);
#pragma unroll
                for (int j = 0; j < 4; ++j) ss += o0[j] * o0[j] + o1[j] * o1[j];
            }
            ss += __shfl_xor(ss, 16); ss += __shfl_xor(ss, 32);
            if (fq == 0) atomicAdd(ssq + row, ss);
            asm volatile("" ::: "memory");
        }
#undef GATE_LOAD
    }
};

struct Args { const float* in[16]; float* out; unsigned char* ws; int ph_lo, ph_hi; };
enum { I_X = 0, I_P, I_NG, I_WIN, I_CAW, I_PW, I_PS, I_CCW, I_CCB, I_LNG, I_LNB, I_WBO, I_WO, I_WPG, I_WPP, I_FNG };

__device__ __forceinline__ void transpose_item(const float* __restrict__ W, int N, bf16_t* __restrict__ WT, int ldT, int k0, int n0, const float* __restrict__ kscale, LAS float* scr, int lane, int d0 = -1) {
    if (d0 < 0) d0 = n0;
    const int r = lane >> 4, c4 = lane & 15;
    f32x4 v[16]; float ks[16];
#pragma unroll
    for (int i = 0; i < 16; ++i) { const int kk = 4 * i + r; v[i] = __builtin_nontemporal_load((const f32x4*)(W + (size_t)(k0 + kk) * N + n0 + 4 * c4)); ks[i] = kscale ? kscale[k0 + kk] : 1.0f; }
    asm volatile("" ::: "memory");
#pragma unroll
    for (int i = 0; i < 16; ++i) { const int kk = 4 * i + r; const f32x4 w = v[i] * ks[i];
        LAS float* sp = scr + kk * 65 + 4 * c4; sp[0] = w[0]; sp[1] = w[1]; sp[2] = w[2]; sp[3] = w[3]; }
    asm volatile("s_waitcnt lgkmcnt(0)" ::: "memory");
    const int c = lane & 7;
#pragma unroll
    for (int j = 0; j < 8; ++j) { const int nn = (lane >> 3) + 8 * j; const LAS float* s = scr + (8 * c) * 65 + nn;
        u32x4 o; o.x = cvt_pk_bf16(s[0 * 65], s[1 * 65]); o.y = cvt_pk_bf16(s[2 * 65], s[3 * 65]); o.z = cvt_pk_bf16(s[4 * 65], s[5 * 65]); o.w = cvt_pk_bf16(s[6 * 65], s[7 * 65]);
        *(u32x4*)(WT + (size_t)(d0 + nn) * ldT + k0 + 8 * c) = o; }
    asm volatile("s_waitcnt lgkmcnt(0)" ::: "memory");
}
__device__ __forceinline__ float wave_sum(float v) {
#pragma unroll
    for (int o = 1; o < 64; o <<= 1) v += __shfl_xor(v, o);
    return v;
}
__device__ __forceinline__ void p0_prologue(const Args& a, LAS unsigned char* lds) {
    int tid = threadIdx.x; asm volatile("" : "+v"(tid));
    const int lane = tid & 63, wave = __builtin_amdgcn_readfirstlane(tid >> 6);
    LAS float* scr = (LAS float*)(lds + wave * 16640);
    const int gw = blockIdx.x * 8 + wave, NGW = gridDim.x * 8;
    unsigned char* ws = a.ws;
    constexpr int I_IN = 32 * 240, I_BO = 3 * 16 * 32, I_O = 32 * 32, I_G = 32 * 32, I_PP = 4 * 32, I_PL = 4 * 16;
    constexpr int PER_LAYER = I_IN + I_BO + I_O + I_G + I_PP + I_PL;
    for (int it = gw; it < DEPTH * PER_LAYER; it += NGW) {
        const int l = it / PER_LAYER; int r = it % PER_LAYER;
        if (r < I_IN) { const int kb = r / 240, nb = r % 240;
            const int c0 = 64 * nb, sl = c0 >> 10, e = c0 & 1023, pr = (e >> 7) * 256 + (e & 127); int d0 = c0;
            if (sl == 0) d0 = pr; else if (sl == 2) d0 = pr + 128; else if (sl == 1) d0 = 2048 + pr; else if (sl == 3) d0 = 2048 + pr + 128;
            else if (sl == 4) d0 = 4096 + e; else if (sl == 5) d0 = 5120 + e; else if (sl == 6) d0 = 6144 + pr; else if (sl == 7) d0 = 6144 + pr + 128; else if (sl == 8) d0 = 8192 + e;
            transpose_item(a.in[I_WIN] + (size_t)l * DM * NC, NC, (bf16_t*)(ws + WS_WI + l * SZ_WI), DM, 64 * kb, c0, a.in[I_NG] + l * DM, scr, lane, d0); continue; }
        r -= I_IN;
        if (r < I_BO) { const int n = r / 512, q = r % 512, kb = q / 32, nb = q % 32;
            transpose_item(a.in[I_WBO] + ((size_t)l * 3 + n) * EW * DM, DM, (bf16_t*)(ws + WS_WB + l * SZ_WB) + n * EW, YW, 64 * kb, 64 * nb, nullptr, scr, lane); continue; }
        r -= I_BO;
        if (r < I_O) { const int kb = r / 32, nb = r % 32;
            transpose_item(a.in[I_WO] + (size_t)l * DM * DM, DM, (bf16_t*)(ws + WS_WO + l * SZ_WO), DM, 64 * kb, 64 * nb, nullptr, scr, lane); continue; }
        r -= I_O;
        if (r < I_G) { const int kb = r / 32, nb = r % 32;
            transpose_item(a.in[I_WPG] + (size_t)l * DM * DM, DM, (bf16_t*)(ws + WS_WG + l * SZ_WO), DM, 64 * kb, 64 * nb, nullptr, scr, lane); continue; }
        r -= I_G;
        if (r < I_PP) { const int kb = r / 32, nb = r % 32;
            transpose_item(a.in[I_WPP] + (size_t)l * PD * DM, DM, (bf16_t*)(ws + WS_WP + l * SZ_WP), PD, 64 * kb, 64 * nb, nullptr, scr, lane); continue; }
        r -= I_PP;
        { const int gq = r / 16, q = r % 16, kb = q / 4, nb = q % 4;
            transpose_item(a.in[I_PW] + ((size_t)l * 4 + gq) * 256 * 256, 256, (bf16_t*)(ws + WS_PW + l * SZ_PW) + (size_t)gq * 256 * 256, 256, 64 * kb, 64 * nb, nullptr, scr, lane); }
    }
    float* ssq = (float*)(ws + WS_SSQ);
    bf16_t* hb0 = (bf16_t*)(ws + WS_HB0);
    for (int mrow = gw; mrow < MTOK; mrow += NGW) {
        const f32x4* xr = (const f32x4*)(a.in[I_X] + (size_t)mrow * DM) + lane;
        u32x2* o8 = (u32x2*)(hb0 + (size_t)mrow * DM) + lane;
        float s = 0.f; f32x4 xv[8];
#pragma unroll
        for (int j = 0; j < 8; ++j) xv[j] = __builtin_nontemporal_load(xr + 64 * j);
        asm volatile("" ::: "memory");
#pragma unroll
        for (int j = 0; j < 8; ++j) { const f32x4 v = xv[j]; s += (v[0] * v[0] + v[1] * v[1]) + (v[2] * v[2] + v[3] * v[3]);
            u32x2 w; w.x = cvt_pk_bf16(v[0], v[1]); w.y = cvt_pk_bf16(v[2], v[3]); o8[64 * j] = w; }
        s = wave_sum(s);
        if (lane == 0) { ssq[mrow] = s; ssq[MTOK + mrow] = 0.f; ssq[2 * MTOK + mrow] = 0.f; }
    }
    {
        const f32x4* ps = (const f32x4*)a.in[I_P]; u32x2* pd = (u32x2*)(ws + WS_PB);
        const size_t n4 = (size_t)DEPTH * MTOK * PD / 4, stride = (size_t)gridDim.x * 512;
        size_t i = (size_t)blockIdx.x * 512 + tid;
        for (; i + 3 * stride < n4; i += 4 * stride) { f32x4 v[4];
#pragma unroll
            for (int q = 0; q < 4; ++q) v[q] = __builtin_nontemporal_load(ps + i + q * stride);
            asm volatile("" ::: "memory");
#pragma unroll
            for (int q = 0; q < 4; ++q) { u32x2 w; w.x = cvt_pk_bf16(v[q][0], v[q][1]); w.y = cvt_pk_bf16(v[q][2], v[q][3]); pd[i + q * stride] = w; } }
        for (; i < n4; i += stride) { const f32x4 v = ps[i]; u32x2 w; w.x = cvt_pk_bf16(v[0], v[1]); w.y = cvt_pk_bf16(v[2], v[3]); pd[i] = w; }
    }
}

constexpr int TT = 16;
template <int H, int Q> __device__ __forceinline__ void red_one(float (&x)[2 * TT], bool up) { const float a = x[Q + H], b = x[Q]; const float keep = up ? a : b, send = up ? b : a; x[Q] = keep + __shfl_xor(send, H); }
template <int H, int... Q> __device__ __forceinline__ void red_step(float (&x)[2 * TT], int lane, std::integer_sequence<int, Q...>) { const bool up = (lane & H) != 0; (red_one<H, Q>(x, up), ...); }
__device__ __forceinline__ float wave_reduce32(float (&x)[2 * TT], int lane) {
    static_assert(TT == 16, "reduce written for 32 values");
    red_step<16>(x, lane, std::make_integer_sequence<int, 16>{});
    red_step<8>(x, lane, std::make_integer_sequence<int, 8>{});
    red_step<4>(x, lane, std::make_integer_sequence<int, 4>{});
    red_step<2>(x, lane, std::make_integer_sequence<int, 2>{});
    red_step<1>(x, lane, std::make_integer_sequence<int, 1>{});
    return x[0] + __shfl_xor(x[0], 32);
}
template <int W>
__device__ __forceinline__ void pool_branch(const bf16_t* __restrict__ Pb, bf16_t* __restrict__ out, bool first) {
    unsigned raw[W - 1 + TT];
#pragma unroll
    for (int j = 0; j < W - 1 + TT; ++j) { const int off = j - (W - 1); const int offc = (off < 0 && first) ? 0 : off;
        unsigned r = *(const unsigned*)(Pb + (ptrdiff_t)offc * NCO); if (off < 0 && first) r = 0u; raw[j] = r; }
    asm volatile("" ::: "memory");
    f32x2 S = (f32x2){0.f, 0.f};
#pragma unroll
    for (int j = 0; j < W - 1; ++j) S += un2(raw[j]);
#pragma unroll
    for (int i = 0; i < TT; ++i) {
        const f32x2 ui = un2(raw[i + W - 1]);
        S += ui;
        const float inv = (first && (i + 1 < W)) ? 1.0f / (float)(i + 1) : 1.0f / (float)W;
        st2(out + (size_t)i * EW, S * inv - ui);
        S -= un2(raw[i]);
    }
}
constexpr int CSTEPS = TT + 30;
template <int NDEAD, int B>
__device__ __forceinline__ void conv31_load(const bf16_t* __restrict__ Pt, unsigned (&cv)[8]) {
#pragma unroll
    for (int q = 0; q < 8; ++q) { const int JJ = 8 * B + q; if (JJ >= NDEAD && JJ < CSTEPS) cv[q] = *(const unsigned*)(Pt + (ptrdiff_t)(JJ - 30) * NCO + OV); }
}
template <int NDEAD, int B>
__device__ __forceinline__ void conv31_comp(const unsigned (&cv)[8], const f32x2 (&wk)[31], f32x2 (&acc)[TT]) {
#pragma unroll
    for (int q = 0; q < 8; ++q) { const int JJ = 8 * B + q; if (JJ >= NDEAD && JJ < CSTEPS) { const f32x2 v = un2(cv[q]);
#pragma unroll
        for (int i = 0; i < TT; ++i) { const int k = JJ - i; if (k >= 0 && k <= 30) acc[i] += wk[k] * v; } } }
}
#define MIX_ISSUED() asm volatile("" ::: "memory")
template <int NDEAD>
__device__ __forceinline__ void conv31_all(const bf16_t* __restrict__ Pt, const f32x2 (&wk)[31], f32x2 (&acc)[TT]) {
    static_assert(CSTEPS <= 48, "six batches of eight steps");
    unsigned cA[8], cB[8];
    conv31_load<NDEAD, 0>(Pt, cA); conv31_load<NDEAD, 1>(Pt, cB); MIX_ISSUED();
    conv31_comp<NDEAD, 0>(cA, wk, acc); conv31_load<NDEAD, 2>(Pt, cA); MIX_ISSUED();
    conv31_comp<NDEAD, 1>(cB, wk, acc); conv31_load<NDEAD, 3>(Pt, cB); MIX_ISSUED();
    conv31_comp<NDEAD, 2>(cA, wk, acc); conv31_load<NDEAD, 4>(Pt, cA); MIX_ISSUED();
    conv31_comp<NDEAD, 3>(cB, wk, acc); conv31_load<NDEAD, 5>(Pt, cB); MIX_ISSUED();
    conv31_comp<NDEAD, 4>(cA, wk, acc);
    conv31_comp<NDEAD, 5>(cB, wk, acc);
}

__device__ __forceinline__ void mixer_phase(const Args& a, int l, LAS unsigned char* lds, int tile0, int tstride, int tend) {
    int tid = threadIdx.x; asm volatile("" : "+v"(tid));
    const int lane = tid & 63, wave = __builtin_amdgcn_readfirstlane(tid >> 6);
    const int e0 = 2 * tid;
    const bf16_t* P = (const bf16_t*)(a.ws + WS_PROJ + (size_t)l * SZ_PROJ);
    bf16_t* Y = (bf16_t*)(a.ws + WS_Y);
    bf16_t* PO = (bf16_t*)(a.ws + WS_POOL);
    LAS float* red = (LAS float*)lds;
    LAS float* fin = (LAS float*)(lds + 1024);
    for (int ti = tile0; ti < tend; ti += tstride) {
        const int t0 = ti * TT, s0 = t0 % SEQ; const bool first = (s0 == 0);
        const bf16_t* Pt = P + (size_t)t0 * NCO + e0;
        {
            const float* cw = a.in[I_CAW] + (size_t)l * 3 * EW + e0;
            const f32x2 w0 = *(const f32x2*)cw, w1 = *(const f32x2*)(cw + EW), w2 = *(const f32x2*)(cw + 2 * EW);
            f32x2 q2 = (f32x2){0.f, 0.f}, q1 = (f32x2){0.f, 0.f};
            if (!first) { q2 = ld2(Pt - 2 * (ptrdiff_t)NCO + OQ); q1 = ld2(Pt - (ptrdiff_t)NCO + OQ); }
            unsigned rA[TT][2];
#pragma unroll
            for (int i = 0; i < TT; ++i) { const bf16_t* pr = Pt + (size_t)i * NCO; rA[i][0] = *(const unsigned*)(pr + OQ); rA[i][1] = *(const unsigned*)(pr + OAB); }
            MIX_ISSUED();
#pragma unroll
            for (int i = 0; i < TT; ++i) {
                const f32x2 q = un2(rA[i][0]), abz = un2(rA[i][1]);
                const f32x2 cv = w0 * q2 + w1 * q1 + w2 * q;
                st2(Y + (size_t)(t0 + i) * YW + e0, abz * cv);
                q2 = q1; q1 = q;
            }
        }
        asm volatile("" ::: "memory");
        {
            const bf16_t* Pb = Pt + OBIN; bf16_t* po = PO + (size_t)t0 * EW + e0;
            const int grp = wave >> 1;
            if (grp == 0) pool_branch<2>(Pb, po, first);
            else if (grp == 1) pool_branch<4>(Pb, po, first);
            else if (grp == 2) pool_branch<8>(Pb, po, first);
            else pool_branch<16>(Pb, po, first);
        }
        asm volatile("" ::: "memory");
        {
            const float* cw = a.in[I_CCW] + (size_t)l * 31 * EW + e0;
            f32x2 wk[31];
#pragma unroll
            for (int k = 0; k < 31; ++k) wk[k] = *(const f32x2*)(cw + (size_t)k * EW);
            const f32x2 bias = *(const f32x2*)(a.in[I_CCB] + (size_t)l * EW + e0);
            f32x2 acc[TT];
#pragma unroll
            for (int i = 0; i < TT; ++i) acc[i] = bias;
            if (s0 == 0) conv31_all<30>(Pt, wk, acc);
            else if (s0 == TT) conv31_all<30 - TT>(Pt, wk, acc);
            else conv31_all<0>(Pt, wk, acc);
            float st[2 * TT];
#pragma unroll
            for (int i = 0; i < TT; ++i) { st[2 * i] = acc[i].x + acc[i].y; st[2 * i + 1] = acc[i].x * acc[i].x + acc[i].y * acc[i].y; }
            const float tot = wave_reduce32(st, lane);
            __syncthreads();
            if (lane < 32) red[wave * 32 + lane] = tot;
            __syncthreads();
            if (tid < 32) { float s = 0.f;
#pragma unroll
                for (int w = 0; w < 8; ++w) s += red[w * 32 + tid];
                fin[tid] = s; }
            __syncthreads();
            const f32x2 lg = *(const f32x2*)(a.in[I_LNG] + (size_t)l * EW + e0), lb = *(const f32x2*)(a.in[I_LNB] + (size_t)l * EW + e0);
            unsigned rz[TT];
#pragma unroll
            for (int i = 0; i < TT; ++i) rz[i] = *(const unsigned*)(Pt + (size_t)i * NCO + OCZ);
            MIX_ISSUED();
#pragma unroll
            for (int i = 0; i < TT; ++i) {
                const float mean = fin[2 * i] * (1.0f / EW);
                const float var = fmaxf(fin[2 * i + 1] * (1.0f / EW) - mean * mean, 0.f);
                const float rstd = __builtin_amdgcn_rsqf(var + LN_EPS);
                f32x2 y = (acc[i] - mean) * rstd * lg + lb;
                y.x = silu_f(y.x); y.y = silu_f(y.y);
                st2(Y + (size_t)(t0 + i) * YW + 2 * EW + e0, y * un2(rz[i]));
            }
        }
    }
}

__device__ __forceinline__ void final_phase(const Args& a, int gw, int NGW, int row0, int row1) {
    int tid = threadIdx.x; asm volatile("" : "+v"(tid));
    const int lane = tid & 63, wave = tid >> 6;
    gw += wave;
    const float* ssq = (const float*)(a.ws + WS_SSQ) + 2 * MTOK;
    const bf16_t* HB = (const bf16_t*)(a.ws + WS_HB0);
    const f32x4* fg = (const f32x4*)a.in[I_FNG] + 2 * lane;
    for (int mrow = row0 + gw; mrow < row1; mrow += NGW) {
        const float rs = __builtin_amdgcn_rsqf(ssq[mrow] * (1.0f / DM) + RMS_EPS);
        const u32x4* hr = (const u32x4*)(HB + (size_t)mrow * DM) + lane; f32x4* orow = (f32x4*)(a.out + (size_t)mrow * DM) + 2 * lane;
        u32x4 hv[4];
#pragma unroll
        for (int j = 0; j < 4; ++j) hv[j] = hr[64 * j];
        asm volatile("" ::: "memory");
#pragma unroll
        for (int j = 0; j < 4; ++j) { f32x4 h0, h1; unpack8(hv[j], h0, h1); orow[128 * j] = h0 * rs * fg[128 * j]; orow[128 * j + 1] = h1 * rs * fg[128 * j + 1]; }
    }
}

#define XB_TMO      128
#define XB_XCNT(j)  (256  + 64 * (j))
#define XB_XSUB(j)  (1280 + 64 * (j))
#define XB_XGEN(j)  (2304 + 64 * (j))
#define XB_TOP      3328
#define XB_TOPGEN   3392
#define XCD_BAR_WORDS 3456
#define XB_SPIN_CAP (1u << 20)
__device__ __forceinline__ unsigned xb_ld(unsigned* p)              { return __hip_atomic_load(p, __ATOMIC_RELAXED, __HIP_MEMORY_SCOPE_AGENT); }
__device__ __forceinline__ unsigned xb_add(unsigned* p, unsigned v) { return __hip_atomic_fetch_add(p, v, __ATOMIC_RELAXED, __HIP_MEMORY_SCOPE_AGENT); }
__device__ __forceinline__ unsigned xb_xcc_id() { return (unsigned)__builtin_amdgcn_s_getreg((3 << 11) | 20) & 0xFu; }
#define XB_SPIN(cond, bar) do { unsigned _sp = 0; while (cond) { __builtin_amdgcn_s_sleep(1); \
    if ((++_sp & 255u) == 0u) { if (xb_ld(&(bar)[XB_TMO])) break; if (_sp > XB_SPIN_CAP) { atomicAdd(&(bar)[XB_TMO], 1u); break; } } } } while (0)
struct XcdBarrier { unsigned* bar; unsigned x; volatile LAS unsigned* st; };
__device__ __forceinline__ XcdBarrier xcd_barrier_post(unsigned* bar, volatile LAS unsigned* st) {
    XcdBarrier b; b.bar = bar; b.x = xb_xcc_id(); b.st = st;
    if (threadIdx.x == 0) st[2] = xb_add(&bar[XB_XCNT(b.x)], 1u);
    return b;
}
__device__ __forceinline__ void xcd_barrier_complete(unsigned* bar, unsigned x, unsigned& nloc, unsigned& nx) {
    const unsigned G = gridDim.x * gridDim.y * gridDim.z;
    unsigned sum, cnt, mine, sp = 0u;
    for (;;) {
        sum = 0u; cnt = 0u; mine = 0u;
#pragma unroll
        for (unsigned j = 0; j < 16; ++j) { const unsigned c = xb_ld(&bar[XB_XCNT(j)]); sum += c; cnt += (c > 0u) ? 1u : 0u; mine = (j == x) ? c : mine; }
        if (sum == G) break;
        __builtin_amdgcn_s_sleep(1);
        if ((++sp & 255u) == 0u) { if (xb_ld(&bar[XB_TMO])) break; if (sp > XB_SPIN_CAP) { atomicAdd(&bar[XB_TMO], 1u); break; } }
    }
    nloc = mine > 0u ? mine : 1u; nx = cnt > 0u ? cnt : 1u;
}
__device__ __forceinline__ void xcd_barrier(const XcdBarrier& b, bool local = false) {
    asm volatile("s_waitcnt vmcnt(0)" ::: "memory");
    __syncthreads();
    if (threadIdx.x == 0) {
        unsigned* bar = b.bar;
        __builtin_amdgcn_s_waitcnt(0);
        unsigned nloc = b.st[0], nx = b.st[1];
        if (nloc == 0u) { xcd_barrier_complete(bar, b.x, nloc, nx); b.st[0] = nloc; b.st[1] = nx; }
        const unsigned old = xb_add(&bar[XB_XSUB(b.x)], 1u);
        const unsigned gen = old / nloc;
        if (old + 1u == (gen + 1u) * nloc) {
            if (!local) {
            __builtin_amdgcn_fence(__ATOMIC_RELEASE, "agent");
            asm volatile("s_waitcnt vmcnt(0)" ::: "memory");
            const unsigned og = xb_add(&bar[XB_TOP], 1u);
            const unsigned tg = og / nx;
            if (og + 1u == (tg + 1u) * nx) xb_add(&bar[XB_TOPGEN], 1u);
            else XB_SPIN(xb_ld(&bar[XB_TOPGEN]) == tg, bar);
            }
            __builtin_amdgcn_fence(__ATOMIC_ACQUIRE, "agent");
            xb_add(&bar[XB_XGEN(b.x)], 1u);
            asm volatile("s_waitcnt vmcnt(0)" ::: "memory");
        } else {
            XB_SPIN(xb_ld(&bar[XB_XGEN(b.x)]) == gen, bar);
            __builtin_amdgcn_fence(__ATOMIC_ACQUIRE, "agent");
            asm volatile("s_waitcnt vmcnt(0)" ::: "memory");
        }
    }
    __syncthreads();
}

__global__ void __launch_bounds__(512, 2) fwd_megakernel(Args a) {
    extern __shared__ __attribute__((aligned(16))) unsigned char lds_raw[];
    LAS unsigned char* lds = (LAS unsigned char*)lds_raw;
    cg::grid_group grid = cg::this_grid();
    unsigned char* ws = a.ws;
    const int lo = a.ph_lo, hi = a.ph_hi;
#ifndef PH_MASK
#define PH_MASK 0xffff
#endif
#define KIND(b) ((PH_MASK >> (b)) & 1)
#define IN(k) (lo <= (k) && (k) < hi)
#define SEAM(k) do { if (IN(k) && IN((k) + 1)) { if (lo < 0) grid.sync(); else xcd_barrier(xb); } } while (0)
#define SEAML(k) do { if (IN(k) && IN((k) + 1)) xcd_barrier(xb, lx >= 0); } while (0)
    volatile LAS unsigned* xst = (volatile LAS unsigned*)(lds + LDS_BYTES - 16);
    if (threadIdx.x < 4) xst[threadIdx.x] = 0u;
    __syncthreads();
    XcdBarrier xb = xcd_barrier_post((unsigned*)(ws + WS_BAR), xst);
    float* ssq = (float*)(ws + WS_SSQ);
    bf16_t* hb0 = (bf16_t*)(ws + WS_HB0); bf16_t* hb1 = (bf16_t*)(ws + WS_HB1);
    bf16_t* Y = (bf16_t*)(ws + WS_Y); bf16_t* MG = (bf16_t*)(ws + WS_MG);

    if (IN(0) && KIND(0)) { p0_prologue(a, lds); __syncthreads(); }
    SEAM(0);
    int lx = -1, lr = 0;
    if (IN(0) && IN(1) && gridDim.x == 256u && xb.x < 8u) {
        unsigned* bar = (unsigned*)(ws + WS_BAR); bool even = true;
#pragma unroll
        for (unsigned j = 0; j < 16; ++j) { const unsigned cj = xb_ld(&bar[XB_XCNT(j)]); even = even && (cj == (j < 8u ? 32u : 0u)); }
        const unsigned rank = xst[2];
        if (even && rank < 32u) { lx = (int)xb.x; lr = (int)rank; }
    }
    lx = __builtin_amdgcn_readfirstlane(lx); lr = __builtin_amdgcn_readfirstlane(lr);
    for (int l = 0; l < DEPTH; ++l) {
        const int pb = 1 + 6 * l;
        bf16_t* PROJ = (bf16_t*)(ws + WS_PROJ + (size_t)l * SZ_PROJ);
        if (IN(pb) && KIND(2)) {
            constexpr int TFULL = NC / 256 - 4;
            { pg8::Gemm g{hb0, (const bf16_t*)(ws + WS_WI + l * SZ_WI), DM, DM, DM, MTOK / 256, TFULL, 0, lx, lr};
              EpiProj E{PROJ, ssq + l * MTOK, 0};
              pg8::gemm_phase<EpiProj>(lds, g, E); }
            { pg8::Gemm g{hb0, (const bf16_t*)(ws + WS_WI + l * SZ_WI) + (size_t)TFULL * 256 * DM, DM, DM, DM, MTOK / 256, 4, 0, lx, lr};
              EpiProj E{PROJ, ssq + l * MTOK, TFULL};
              pg8::gemm_phase<EpiProj, pg8::HalfNOrder, true>(lds, g, E); }
        }
        SEAM(pb);
        if (IN(pb + 1) && KIND(3)) {
            if (lx >= 0) mixer_phase(a, l, lds, lx * (MTOK / TT / 8) + lr, 32, (lx + 1) * (MTOK / TT / 8));
            else mixer_phase(a, l, lds, (int)blockIdx.x, (int)gridDim.x, MTOK / TT);
            __syncthreads(); }
        SEAML(pb + 1);
        if (IN(pb + 2) && KIND(4)) {
            pg8::Gemm g{(const bf16_t*)(ws + WS_POOL), (const bf16_t*)(ws + WS_PW + l * SZ_PW), EW, 256, 256, MTOK / 256, 4, 256, lx, lr};
            EpiPool E{Y, a.in[I_PS] + (size_t)l * EW, PROJ};
            pg8::gemm_phase<EpiPool>(lds, g, E);
            if (KIND(1)) {
                pg8::Gemm gq{(const bf16_t*)(ws + WS_PB + l * SZ_PB), (const bf16_t*)(ws + WS_WP + l * SZ_WP), PD, PD, PD, MTOK / 256, DM / 256, 0, lx, lr};
                EpiPlain Eq{(bf16_t*)(ws + WS_PLE + l * SZ_ACT), DM};
                pg8::gemm_phase<EpiPlain, pg8::IdleOrder>(lds, gq, Eq);
            }
        }
        SEAML(pb + 2);
        if (IN(pb + 3) && KIND(5)) {
            pg8::Gemm g{Y, (const bf16_t*)(ws + WS_WB + l * SZ_WB), YW, YW, YW, MTOK / 256, DM / 256, 0, lx, lr};
            EpiMerge E{PROJ, MG};
            pg8::gemm_phase<EpiMerge>(lds, g, E);
        }
        SEAML(pb + 3);
        if (IN(pb + 4) && KIND(6)) {
            pg8::Gemm g{MG, (const bf16_t*)(ws + WS_WO + l * SZ_WO), DM, DM, DM, MTOK / 256, DM / 256, 0, lx, lr};
            EpiWo E{l == 0 ? a.in[I_X] : (const float*)nullptr, hb0, hb1};
            pg8::gemm_phase<EpiWo>(lds, g, E);
        }
        SEAML(pb + 4);
        if (IN(pb + 5) && KIND(7)) {
            pg8::Gemm g{hb1, (const bf16_t*)(ws + WS_WG + l * SZ_WO), DM, DM, DM, MTOK / 256, DM / 256, 0, lx, lr};
            EpiGate E{hb1, (const bf16_t*)(ws + WS_PLE + l * SZ_ACT), hb0, ssq + (l + 1) * MTOK};
            pg8::gemm_phase<EpiGate>(lds, g, E);
        }
        SEAML(pb + 5);
    }
    if (IN(13) && KIND(8)) {
        if (lx >= 0) final_phase(a, lr * 8, 256, lx * 1024, lx * 1024 + 1024);
        else final_phase(a, (int)blockIdx.x * 8, (int)gridDim.x * 8, 0, MTOK);
    }
#undef IN
#undef SEAM
}

#ifndef MK_NLAUNCH
#define MK_NLAUNCH 1
#endif
extern "C" void kernel_launch(void* const* d_in, const int* in_sizes, int n_in, void* d_out, int out_size, void* d_ws, size_t ws_size, hipStream_t stream) {
    static int grid = 0;
    if (grid == 0) {
        if (n_in != 16 || ws_size < WS_END) { fprintf(stderr, "kernel_launch: expected 16 inputs and >= %zu bytes of workspace (got %d, %zu)\n", (size_t)WS_END, n_in, ws_size); grid = -1; return; }
        int dev = 0, cus = 0, per_cu = 0;
        hipGetDevice(&dev);
        hipDeviceGetAttribute(&cus, hipDeviceAttributeMultiprocessorCount, dev);
        if (hipFuncSetAttribute((const void*)fwd_megakernel, hipFuncAttributeMaxDynamicSharedMemorySize, LDS_BYTES) != hipSuccess) { fprintf(stderr, "kernel_launch: hipFuncSetAttribute failed\n"); grid = -1; return; }
        if (hipOccupancyMaxActiveBlocksPerMultiprocessor(&per_cu, (const void*)fwd_megakernel, 512, LDS_BYTES) != hipSuccess || per_cu < 1) { fprintf(stderr, "kernel_launch: occupancy query says %d\n", per_cu); per_cu = 1; }
        (void)hipGetLastError();
        grid = cus * 1;
        fprintf(stderr, "kernel_launch: grid %d (cus %d, per_cu %d)\n", grid, cus, per_cu);
    }
    if (grid < 0) return;
    if (hipMemsetAsync((char*)d_ws + WS_BAR, 0, XCD_BAR_WORDS * 4, stream) != hipSuccess) { fprintf(stderr, "kernel_launch: memset of the barrier words failed\n"); return; }
    Args a{};
    for (int i = 0; i < 16; ++i) a.in[i] = (const float*)d_in[i];
    a.out = (float*)d_out; a.ws = (unsigned char*)d_ws;
#if MK_NLAUNCH == 1
    a.ph_lo = 0; a.ph_hi = 14;
    { void* args[] = {&a}; hipError_t e = hipLaunchCooperativeKernel((const void*)fwd_megakernel, dim3(grid), dim3(512), args, LDS_BYTES, stream);
      if (e != hipSuccess) fprintf(stderr, "cooperative launch failed: %s (grid %d)\n", hipGetErrorString(e), grid); }
#else
    for (int ph = 0; ph < 14; ++ph) { a.ph_lo = ph; a.ph_hi = ph + 1; void* args[] = {&a};
        hipError_t e = hipLaunchCooperativeKernel((const void*)fwd_megakernel, dim3(grid), dim3(512), args, LDS_BYTES, stream);
        if (e != hipSuccess) { fprintf(stderr, "launch %d failed: %s\n", ph, hipGetErrorString(e)); break; } }
#endif
}
```

```cpp
#include <hip/hip_runtime.h>
#include <hip/hip_cooperative_groups.h>
#include <cstdio>
#include <cstdint>
#include <utility>
namespace cg = cooperative_groups;

#define LAS __attribute__((address_space(3)))
typedef unsigned short bf16_t;
typedef short bf16x8 __attribute__((ext_vector_type(8)));
typedef float f32x4 __attribute__((ext_vector_type(4)));
typedef float f32x2 __attribute__((ext_vector_type(2)));
typedef unsigned u32x4 __attribute__((ext_vector_type(4)));
typedef unsigned u32x2 __attribute__((ext_vector_type(2)));

constexpr int MTOK = 8192, DM = 2048, EW = 1024, NC = 15360, PD = 256, SEQ = 2048, DEPTH = 2;
constexpr int YW = 3 * EW;
constexpr int NCO = 9 * EW;
constexpr int OQ = 0, OAB = EW, OBIN = 2 * EW, OBZ = 3 * EW, OV = 4 * EW, OCZ = 5 * EW;
constexpr int GATE_B0 = 12 * EW;
constexpr size_t ROWB = (size_t)NCO * 2;
constexpr float RMS_EPS = 1e-6f, LN_EPS = 1e-5f;

constexpr size_t WS_SSQ = 0;
constexpr size_t WS_BAR = 128 << 10;
constexpr size_t WS_WI = 1 << 20;
constexpr size_t SZ_WI = (size_t)NC * DM * 2;
constexpr size_t WS_WB = WS_WI + 2 * SZ_WI;
constexpr size_t SZ_WB = (size_t)DM * YW * 2;
constexpr size_t WS_WO = WS_WB + 2 * SZ_WB;
constexpr size_t SZ_WO = (size_t)DM * DM * 2;
constexpr size_t WS_WG = WS_WO + 2 * SZ_WO;
constexpr size_t WS_WP = WS_WG + 2 * SZ_WO;
constexpr size_t SZ_WP = (size_t)DM * PD * 2;
constexpr size_t WS_PW = WS_WP + 2 * SZ_WP;
constexpr size_t SZ_PW = (size_t)EW * 256 * 2;
constexpr size_t WS_PB = WS_PW + 2 * SZ_PW;
constexpr size_t SZ_PB = (size_t)MTOK * PD * 2;
constexpr size_t WS_PLE = WS_PB + 2 * SZ_PB;
constexpr size_t SZ_ACT = (size_t)MTOK * DM * 2;
constexpr size_t WS_HB0 = WS_PLE + 2 * SZ_ACT;
constexpr size_t WS_HB1 = WS_HB0 + SZ_ACT;
constexpr size_t WS_MG = WS_HB1 + SZ_ACT;
constexpr size_t WS_H = WS_MG + SZ_ACT;
constexpr size_t WS_PROJ = WS_H + 2 * SZ_ACT;
constexpr size_t WS_POOL = WS_PROJ + (size_t)MTOK * NC * 2;
constexpr size_t WS_Y = WS_POOL + (size_t)MTOK * EW * 2;
constexpr size_t WS_END = WS_Y + (size_t)MTOK * YW * 2;

constexpr int LDS_BYTES = 147456;

typedef __bf16 bf16x2_t __attribute__((ext_vector_type(2)));
__device__ __forceinline__ unsigned cvt_pk_bf16(float lo, float hi) { const bf16x2_t r = __builtin_convertvector((f32x2){lo, hi}, bf16x2_t); return __builtin_bit_cast(unsigned, r); }
__device__ __forceinline__ float bf_lo(unsigned u) { return __uint_as_float(u << 16); }
__device__ __forceinline__ float bf_hi(unsigned u) { return __uint_as_float(u & 0xffff0000u); }
__device__ __forceinline__ f32x2 ld2(const bf16_t* p) { const unsigned u = *(const unsigned*)p; return (f32x2){bf_lo(u), bf_hi(u)}; }
__device__ __forceinline__ f32x2 un2(unsigned u) { return (f32x2){bf_lo(u), bf_hi(u)}; }
__device__ __forceinline__ void st2(bf16_t* p, f32x2 v) { *(unsigned*)p = cvt_pk_bf16(v.x, v.y); }
__device__ __forceinline__ float sigmoid_f(float x) { return __builtin_amdgcn_rcpf(1.0f + __builtin_amdgcn_exp2f(-1.4426950409f * x)); }
__device__ __forceinline__ float silu_f(float x) { return x * sigmoid_f(x); }
__device__ __forceinline__ u32x4 pack8(f32x4 a, f32x4 b) { u32x4 w; w.x = cvt_pk_bf16(a[0], a[1]); w.y = cvt_pk_bf16(a[2], a[3]); w.z = cvt_pk_bf16(b[0], b[1]); w.w = cvt_pk_bf16(b[2], b[3]); return w; }
__device__ __forceinline__ void unpack8(u32x4 g, f32x4& a, f32x4& b) { a = (f32x4){bf_lo(g.x), bf_hi(g.x), bf_lo(g.y), bf_hi(g.y)}; b = (f32x4){bf_lo(g.z), bf_hi(g.z), bf_lo(g.w), bf_hi(g.w)}; }

__device__ __forceinline__ unsigned pk_unorm8(f32x4 v) { const unsigned b0 = (unsigned)(v[0] * 255.0f + 0.5f), b1 = (unsigned)(v[1] * 255.0f + 0.5f), b2 = (unsigned)(v[2] * 255.0f + 0.5f), b3 = (unsigned)(v[3] * 255.0f + 0.5f); return b0 | (b1 << 8) | (b2 << 16) | (b3 << 24); }
__device__ __forceinline__ f32x4 un_unorm8(unsigned w) { return (f32x4){fmaxf((float)(w & 255u), 0.5f), fmaxf((float)((w >> 8) & 255u), 0.5f), fmaxf((float)((w >> 16) & 255u), 0.5f), fmaxf((float)(w >> 24), 0.5f)}; }
namespace pg8 {
constexpr int BM = 256, BK = 64, HALF = 128, HTB = HALF * BK * 2, STAGE_BYTES = 8 * HTB, NXCD = 8, WGM = 8;
__host__ __device__ __forceinline__ int lds_byte(int r, int c) { const int st = (r >> 4) * 2 + (c >> 5), rr = r & 15, cc = c & 31, ob = rr * 64 + cc * 2; return st * 1024 + (ob ^ (((ob >> 9) & 1) << 5)); }
__host__ __device__ __forceinline__ void stage_rc(int b, int& R, int& C) { const int st = b / 1024, sb = b % 1024, swz = sb ^ (((sb >> 9) & 1) << 5); R = (st >> 1) * 16 + swz / 64; C = (st & 1) * 32 + (swz % 64) / 2; }
__host__ __device__ __forceinline__ int perm32(int rho) { const int n = rho >> 4, i = rho & 15; return 8 * (i >> 2) + 4 * n + (i & 3); }

struct Unit { int pm, pn, half; };
struct Gemm { const bf16_t* A; const bf16_t* Bt; int lda, ldb, K, nM, nN, a_pn_off, lx, lr; };

struct StaticOrder {
    int nM, nN, nwg, G, c, lx, lr;
    __device__ void init(int nM_, int nN_, int G_, int c_) { nM = nM_; nN = nN_; nwg = nM * nN; G = G_; c = c_; lx = -1; lr = 0; }
    __device__ void map(int L, Unit& u) const {
        int wgid = L; { const int q = nwg / NXCD, r = nwg % NXCD, xcd = wgid % NXCD, off = wgid / NXCD; wgid = (xcd < r ? xcd * (q + 1) : r * (q + 1) + (xcd - r) * q) + off; }
        const int nig = WGM * nN, gid = wgid / nig, fm = gid * WGM, gsz = (nM - fm) < WGM ? (nM - fm) : WGM;
        u.pm = fm + ((wgid % nig) % gsz); u.pn = (wgid % nig) / gsz; u.half = 0;
    }
    __device__ bool next(int i, Unit& u) const {
        if (lx >= 0) { const int pn = i * 8 + (lr >> 2); if (pn >= nN) return false; u.pm = 4 * lx + (lr & 3); u.pn = pn; u.half = 0; return true; }
        const long L = (long)i * G + c; if (L >= nwg) return false; map((int)L, u); return true; }
};

struct HalfNOrder : StaticOrder {
    __device__ bool next(int i, Unit& u) const {
        if (lx >= 0) { if (i > 0) return false; const int rr = lr >> 2; u.pm = 4 * lx + (lr & 3); u.pn = rr >> 1; u.half = 1 + (rr & 1); return u.pn < nN; }
        const long L = (long)i * G + c; if (L >= 2L * nwg) return false;
        const int lab = (int)(L & 7), idx = (int)(L >> 3), ppl = nM >> 3, r = idx / ppl;
        u.pm = lab * ppl + idx % ppl; u.pn = r >> 1; u.half = 1 + (r & 1); return true;
    }
};

struct SplitKOrder : StaticOrder {
    __device__ bool next(int i, Unit& u) const { if (i > 0 || lx < 0) return false; const int t = lr & 15; u.pm = 4 * lx + (t & 3); u.pn = t >> 2; u.half = lr >> 4; return true; }
};

struct IdleOrder : StaticOrder {
    static constexpr int PREV_TILES = (MTOK / 256) * (NC / 256);
    __device__ bool next(int i, Unit& u) const {
        if (lx >= 0) { if (lr < 16) return false; const int idx = i * 16 + (lr - 16); if (idx >= 4 * nN) return false; u.pm = 4 * lx + (idx & 3); u.pn = idx >> 2; u.half = 0; return true; }
        const int busy = G / 2;
        if (c < busy) return false;
        const long L = (long)i * (G - busy) + (c - busy); if (L >= nwg) return false; map((int)L, u); return true;
    }
};

template <class Epi, class Order = StaticOrder, int MODE = 0>
__device__ __forceinline__ void gemm_phase(LAS unsigned char* lds, const Gemm g, const Epi& E) {
    constexpr bool HALFN = (MODE == 1), SPLITK = (MODE == 2);
    int tid = threadIdx.x; asm volatile("" : "+v"(tid));
    const int wid = __builtin_amdgcn_readfirstlane(tid >> 6), lane = tid & 63, wr = wid >> 2, wc = wid & 3, fr = lane & 15, fq = lane >> 4;
    const int K = g.K, nt = K / BK;
    Order S; S.init(g.nM, g.nN, (int)gridDim.x, (int)blockIdx.x); S.lx = g.lx; S.lr = g.lr;
    unsigned voffA[2], voffB[2];
#pragma unroll
    for (int i = 0; i < 2; ++i) { int R, C; stage_rc(tid * 16 + i * 8192, R, C); const int Rb = (R & ~31) + perm32(R & 31);
        voffA[i] = (unsigned)(R * g.lda + C) * 2u; voffB[i] = (unsigned)(Rb * g.ldb + C) * 2u; }
    const size_t kstep = (size_t)(BK * 2);
    const size_t hstepA = (size_t)HALF * g.lda * 2, hstepB = (size_t)HALF * g.ldb * 2;
    const size_t tstepA = 2 * hstepA, tstepB = 2 * hstepB;
    const unsigned ldsw = (unsigned)wid * 1024u;
    const int aoff = lds_byte(wr * 64 + fr, fq * 8), boff = lds_byte(wc * 32 + fr, fq * 8);
#define PG8_SA(b, h) (((b) * 2 + (h)) * HTB)
#define PG8_SB(b, h) ((4 + (b) * 2 + (h)) * HTB)
#define PG8_STAGE(bufoff, gbase, voff) do { _Pragma("unroll") for (int _i = 0; _i < 2; ++_i) \
        __builtin_amdgcn_global_load_lds((const unsigned*)((const char*)(gbase) + (voff)[_i]), (LAS unsigned*)(lds + (bufoff) + ldsw + _i * 8192), 16, 0, 0); } while (0)
#define PG8_LDA(dst, b, h) do { _Pragma("unroll") for (int m = 0; m < 4; ++m) _Pragma("unroll") for (int k = 0; k < 2; ++k) dst[m][k] = *(const LAS bf16x8*)(lds + PG8_SA(b, h) + aoff + m * 2048 + k * 1024); } while (0)
#define PG8_LDB(dst, b, h) do { _Pragma("unroll") for (int n = 0; n < 2; ++n) _Pragma("unroll") for (int k = 0; k < 2; ++k) dst[n][k] = *(const LAS bf16x8*)(lds + PG8_SB(b, h) + boff + n * 2048 + k * 1024); } while (0)
#define PG8_MMA(ai, bj, At, Bt) do { __builtin_amdgcn_s_setprio(1); _Pragma("unroll") for (int m = 0; m < 4; ++m) _Pragma("unroll") for (int n = 0; n < 2; ++n) _Pragma("unroll") for (int k = 0; k < 2; ++k) \
        acc[ai][bj][m][n] = __builtin_amdgcn_mfma_f32_16x16x32_bf16(Bt[n][k], At[m][k], acc[ai][bj][m][n], 0, 0, 0); __builtin_amdgcn_s_setprio(0); } while (0)
#define PG8_WAIT_V(n) asm volatile("s_waitcnt vmcnt(" #n ")" ::: "memory")
#define PG8_WAIT_L(n) asm volatile("s_waitcnt lgkmcnt(" #n ")" ::: "memory")
#define PG8_BAR __builtin_amdgcn_s_barrier()
#define PG8_SCHED __builtin_amdgcn_sched_barrier(0)
    Unit cur, nxt; int ui = 0;
    if (!S.next(0, cur)) return;
    f32x4 acc[2][2][4][2];
    if constexpr (Epi::INIT) E.init(acc, cur, wr, wc, fr, fq);
    else {
#pragma unroll
    for (int a = 0; a < 2; ++a)
#pragma unroll
        for (int b = 0; b < 2; ++b)
#pragma unroll
            for (int m = 0; m < 4; ++m)
#pragma unroll
                for (int n = 0; n < 2; ++n) acc[a][b][m][n] = (f32x4){0.f, 0.f, 0.f, 0.f};
    }
    bf16x8 At[4][2], B0[2][2], B1[2][2];
    const char* cA = (const char*)g.A + (size_t)cur.pm * tstepA + (size_t)cur.pn * g.a_pn_off * 2 + (SPLITK ? (size_t)cur.half * K * 2 + (cur.half ? hstepA : (size_t)0) : (size_t)0);
    const ptrdiff_t hsA = (SPLITK && cur.half) ? -(ptrdiff_t)hstepA : (ptrdiff_t)hstepA; const char* cB = (const char*)g.Bt + (size_t)cur.pn * tstepB + (HALFN ? (size_t)(cur.half - 1) * hstepB : (size_t)0) + (SPLITK ? (size_t)cur.half * K * 2 : (size_t)0);
    PG8_STAGE(PG8_SB(0, 0), cB, voffB); PG8_STAGE(PG8_SB(0, 1), cB + hstepB, voffB); PG8_STAGE(PG8_SA(0, 0), cA, voffA); PG8_STAGE(PG8_SA(0, 1), cA + hsA, voffA);
    if (wr == 1) PG8_BAR;
    PG8_WAIT_V(2); PG8_BAR;
    PG8_STAGE(PG8_SB(1, 0), cB + kstep, voffB); PG8_STAGE(PG8_SA(1, 0), cA + kstep, voffA); PG8_STAGE(PG8_SB(1, 1), cB + hstepB + kstep, voffB);
    PG8_WAIT_V(6); PG8_BAR;
    for (;;) {
        const bool has_next = S.next(ui + 1, nxt);
        const char* nA = has_next ? (const char*)g.A + (size_t)nxt.pm * tstepA + (size_t)nxt.pn * g.a_pn_off * 2 + (SPLITK ? (size_t)nxt.half * K * 2 : (size_t)0) : cA; const char* nB = has_next ? (const char*)g.Bt + (size_t)nxt.pn * tstepB + (HALFN ? (size_t)(nxt.half - 1) * hstepB : (size_t)0) + (SPLITK ? (size_t)nxt.half * K * 2 : (size_t)0) : cB;
#pragma unroll 1
        for (int t = 0; t < nt; t += 2) {
            const bool last = (t == nt - 2);
            if constexpr (Epi::SEAMS) { if (t == Epi::SEAM0 || t == Epi::SEAM1) E.seam(acc, cur, t == Epi::SEAM0 ? 0 : 1, wr, wc, fr, fq); }
            const char* a1 = cA + (size_t)(t + 1) * kstep;
            const char* a2 = last ? nA : cA + (size_t)(t + 2) * kstep; const char* b2 = last ? nB : cB + (size_t)(t + 2) * kstep;
            const char* a3 = a2 + kstep; const char* b3 = b2 + kstep;
            PG8_LDB(B0, 0, 0); if constexpr (!HALFN) PG8_LDB(B1, 0, 1); PG8_SCHED; PG8_LDA(At, 0, 0); PG8_STAGE(PG8_SA(1, 1), a1 + hsA, voffA);
            PG8_WAIT_V(8); PG8_WAIT_L(0); PG8_BAR; PG8_MMA(0, 0, At, B0); if constexpr (!HALFN) PG8_MMA(0, 1, At, B1); PG8_BAR; PG8_SCHED;
            PG8_LDA(At, 0, 1); PG8_STAGE(PG8_SB(0, 0), b2, voffB); PG8_STAGE(PG8_SB(0, 1), b2 + hstepB, voffB); PG8_STAGE(PG8_SA(0, 0), a2, voffA);
            PG8_WAIT_V(8); PG8_WAIT_L(0); PG8_BAR; PG8_MMA(1, 0, At, B0); if constexpr (!HALFN) PG8_MMA(1, 1, At, B1); PG8_BAR; PG8_SCHED;
            PG8_LDB(B0, 1, 0); if constexpr (!HALFN) PG8_LDB(B1, 1, 1); PG8_SCHED; PG8_LDA(At, 1, 0); PG8_STAGE(PG8_SA(0, 1), a2 + hsA, voffA);
            PG8_WAIT_V(8); PG8_WAIT_L(0); PG8_BAR; PG8_MMA(0, 0, At, B0); if constexpr (!HALFN) PG8_MMA(0, 1, At, B1); PG8_BAR; PG8_SCHED;
            PG8_LDA(At, 1, 1); PG8_STAGE(PG8_SB(1, 0), b3, voffB); PG8_STAGE(PG8_SB(1, 1), b3 + hstepB, voffB); PG8_STAGE(PG8_SA(1, 0), a3, voffA);
            PG8_WAIT_V(8); PG8_WAIT_L(0); PG8_BAR; PG8_MMA(1, 0, At, B0); if constexpr (!HALFN) PG8_MMA(1, 1, At, B1); PG8_BAR; PG8_SCHED;
        }
        if (wr == 0) PG8_BAR;
        E(acc, cur, wr, wc, fr, fq);
        if (!has_next) break;
        if constexpr (Epi::INIT) E.init(acc, nxt, wr, wc, fr, fq);
        else {
#pragma unroll
        for (int a = 0; a < 2; ++a)
#pragma unroll
            for (int b = 0; b < 2; ++b)
#pragma unroll
                for (int m = 0; m < 4; ++m)
#pragma unroll
                    for (int n = 0; n < 2; ++n) acc[a][b][m][n] = (f32x4){0.f, 0.f, 0.f, 0.f};
        }
        cur = nxt; cA = nA; cB = nB; ++ui;
        if (wr == 1) PG8_BAR;
    }
    PG8_WAIT_V(0);
    PG8_BAR;
#undef PG8_SA
#undef PG8_SB
#undef PG8_STAGE
#undef PG8_LDA
#undef PG8_LDB
#undef PG8_MMA
#undef PG8_WAIT_V
#undef PG8_WAIT_L
#undef PG8_BAR
#undef PG8_SCHED
}
}
using pg8::Unit;

#define EPI_OPAQUE asm volatile("" : "+v"(fr), "+v"(fq));
#define EPI_ROWS_BEGIN _Pragma("unroll") for (int ai = 0; ai < 2; ++ai) _Pragma("unroll") for (int m = 0; m < 4; ++m) { const int row = u.pm * 256 + ai * 128 + wr * 64 + m * 16 + fr;
#define EPI_COLS_BEGIN _Pragma("unroll") for (int bj = 0; bj < 2; ++bj) { const int col = u.pn * 256 + bj * 128 + wc * 32 + 8 * fq;
#define EPI_END }

struct EpiProj {
    static constexpr bool SEAMS = false, INIT = false; static constexpr int SEAM0 = -1, SEAM1 = -1;
    bf16_t* P; const float* ssq; int pn0;
    __device__ __forceinline__ void seam(f32x4 (&)[2][2][4][2], const Unit&, int, int, int, int, int) const {}
    template <int ACT> __device__ __forceinline__ void body(f32x4 (&acc)[2][2][4][2], const Unit& u, int wr, int wc, int fr, int fq, int obase, const float (&rsv)[2][4]) const {
        EPI_ROWS_BEGIN
            const float rs = rsv[ai][m];
#pragma unroll
            for (int bj = 0; bj < 2; ++bj) { const int col = obase + bj * 128 + wc * 32 + 8 * fq;
                f32x4 v0 = acc[ai][bj][m][0] * rs, v1 = acc[ai][bj][m][1] * rs;
                if (ACT == 1) {
#pragma unroll
                    for (int j = 0; j < 4; ++j) { v0[j] = silu_f(v0[j]); v1[j] = silu_f(v1[j]); } }
                if (ACT == 2) {
#pragma unroll
                    for (int j = 0; j < 4; ++j) { v0[j] = sigmoid_f(v0[j]); v1[j] = sigmoid_f(v1[j]); } }
                __builtin_nontemporal_store(pack8(v0, v1), (u32x4*)(P + (size_t)row * NCO + col));
            }
        EPI_END
    }
    __device__ __forceinline__ void body_gate(f32x4 (&acc)[2][2][4][2], const Unit& u, int wr, int wc, int fr, int fq, int gbase, const float (&rsv)[2][4]) const {
        EPI_ROWS_BEGIN
            const float rs = rsv[ai][m];
#pragma unroll
            for (int bj = 0; bj < 2; ++bj) { if (u.half != 0 && bj == 1) continue;
                const int gcol = gbase + (bj + (u.half == 2 ? 1 : 0)) * 128 + wc * 32 + 8 * fq;
                f32x4 v0 = acc[ai][bj][m][0] * rs, v1 = acc[ai][bj][m][1] * rs;
#pragma unroll
                for (int j = 0; j < 4; ++j) { v0[j] = sigmoid_f(v0[j]); v1[j] = sigmoid_f(v1[j]); }
                u32x2 w; w.x = pk_unorm8(v0); w.y = pk_unorm8(v1);
                *(u32x2*)((unsigned char*)P + (size_t)row * ROWB + GATE_B0 + gcol) = w;
            }
        EPI_END
    }
    template <int ACT> __device__ __forceinline__ void body_pair(f32x4 (&acc)[2][2][4][2], const Unit& u, int wr, int wc, int fr, int fq, int obase, const float (&rsv)[2][4]) const {
        EPI_ROWS_BEGIN
            const float rs = rsv[ai][m]; const int col = obase + wc * 32 + 8 * fq;
            f32x4 a0 = acc[ai][0][m][0] * rs, a1 = acc[ai][0][m][1] * rs, b0 = acc[ai][1][m][0] * rs, b1 = acc[ai][1][m][1] * rs;
            if (ACT == 1) {
#pragma unroll
                for (int j = 0; j < 4; ++j) { b0[j] = silu_f(b0[j]); b1[j] = silu_f(b1[j]); } }
            if (ACT == 2) {
#pragma unroll
                for (int j = 0; j < 4; ++j) { b0[j] = sigmoid_f(b0[j]); b1[j] = sigmoid_f(b1[j]); } }
            __builtin_nontemporal_store(pack8(a0 * b0, a1 * b1), (u32x4*)(P + (size_t)row * NCO + col));
        EPI_END
    }
    __device__ __forceinline__ void operator()(f32x4 (&acc)[2][2][4][2], const Unit& u, int wr, int wc, int fr, int fq) const {
        EPI_OPAQUE
        float rsv[2][4];
#pragma unroll
        for (int ai = 0; ai < 2; ++ai)
#pragma unroll
            for (int m = 0; m < 4; ++m) rsv[ai][m] = ssq[u.pm * 256 + ai * 128 + wr * 64 + m * 16 + fr];
        asm volatile("" ::: "memory");
#pragma unroll
        for (int ai = 0; ai < 2; ++ai)
#pragma unroll
            for (int m = 0; m < 4; ++m) rsv[ai][m] = __builtin_amdgcn_rsqf(rsv[ai][m] * (1.0f / DM) + RMS_EPS);
        const int pn = u.pn + pn0;
        if (pn < 8) body_pair<0>(acc, u, wr, wc, fr, fq, OQ + pn * 128, rsv);
        else if (pn < 16) body_pair<1>(acc, u, wr, wc, fr, fq, OAB + (pn - 8) * 128, rsv);
        else if (pn < 20) body<0>(acc, u, wr, wc, fr, fq, OBIN + (pn - 16) * 256, rsv);
        else if (pn < 24) body<1>(acc, u, wr, wc, fr, fq, OBZ + (pn - 20) * 256, rsv);
        else if (pn < 32) body_pair<2>(acc, u, wr, wc, fr, fq, OV + (pn - 24) * 128, rsv);
        else if (pn < 36) body<1>(acc, u, wr, wc, fr, fq, OCZ + (pn - 32) * 256, rsv);
        else body_gate(acc, u, wr, wc, fr, fq, (pn - 36) * 256, rsv);
    }
};
struct EpiPlain {
    static constexpr bool SEAMS = false, INIT = false; static constexpr int SEAM0 = -1, SEAM1 = -1;
    bf16_t* O; int ldo;
    __device__ __forceinline__ void seam(f32x4 (&)[2][2][4][2], const Unit&, int, int, int, int, int) const {}
    __device__ __forceinline__ void operator()(f32x4 (&acc)[2][2][4][2], const Unit& u, int wr, int wc, int fr, int fq) const {
        EPI_OPAQUE
        EPI_ROWS_BEGIN EPI_COLS_BEGIN
            *(u32x4*)(O + (size_t)row * ldo + col) = pack8(acc[ai][bj][m][0], acc[ai][bj][m][1]);
        EPI_END EPI_END
    }
};
struct EpiPool {
    static constexpr bool SEAMS = false, INIT = false; static constexpr int SEAM0 = -1, SEAM1 = -1;
    bf16_t* Y; const float* pscale; const bf16_t* P;
    __device__ __forceinline__ void seam(f32x4 (&)[2][2][4][2], const Unit&, int, int, int, int, int) const {}
    __device__ __forceinline__ void operator()(f32x4 (&acc)[2][2][4][2], const Unit& u, int wr, int wc, int fr, int fq) const {
        EPI_OPAQUE
#pragma unroll
        for (int ai = 0; ai < 2; ++ai) {
            u32x4 zz[4][2];
#pragma unroll
            for (int m = 0; m < 4; ++m)
#pragma unroll
                for (int bj = 0; bj < 2; ++bj) { const int row = u.pm * 256 + ai * 128 + wr * 64 + m * 16 + fr, col = u.pn * 256 + bj * 128 + wc * 32 + 8 * fq;
                    zz[m][bj] = *(const u32x4*)(P + (size_t)row * NCO + OBZ + col); }
            asm volatile("" ::: "memory");
#pragma unroll
            for (int m = 0; m < 4; ++m)
#pragma unroll
                for (int bj = 0; bj < 2; ++bj) { const int row = u.pm * 256 + ai * 128 + wr * 64 + m * 16 + fr, col = u.pn * 256 + bj * 128 + wc * 32 + 8 * fq;
                    const f32x4 s0 = *(const f32x4*)(pscale + col), s1 = *(const f32x4*)(pscale + col + 4);
                    f32x4 z0, z1; unpack8(zz[m][bj], z0, z1);
                    *(u32x4*)(Y + (size_t)row * YW + EW + col) = pack8(acc[ai][bj][m][0] * s0 * z0, acc[ai][bj][m][1] * s1 * z1); }
            asm volatile("" ::: "memory");
        }
    }
};
struct EpiMerge {
    static constexpr bool SEAMS = true, INIT = false; static constexpr int SEAM0 = EW / 64, SEAM1 = 2 * EW / 64;
    const bf16_t* P; bf16_t* MG;
    __device__ __forceinline__ void seam(f32x4 (&acc)[2][2][4][2], const Unit& u, int n, int wr, int wc, int fr, int fq) const {
        EPI_OPAQUE
#pragma unroll
        for (int ai = 0; ai < 2; ++ai) {
            u32x2 ga[4][2], gb[4][2];
#pragma unroll
            for (int m = 0; m < 4; ++m)
#pragma unroll
                for (int bj = 0; bj < 2; ++bj) { const int row = u.pm * 256 + ai * 128 + wr * 64 + m * 16 + fr, col = u.pn * 256 + bj * 128 + wc * 32 + 8 * fq;
                    const unsigned char* gp = (const unsigned char*)P + (size_t)row * ROWB + GATE_B0 + n * DM + col; ga[m][bj] = *(const u32x2*)gp; gb[m][bj] = *(const u32x2*)(gp + DM); }
#pragma unroll
            for (int m = 0; m < 4; ++m)
#pragma unroll
                for (int bj = 0; bj < 2; ++bj) { const f32x4 a0 = un_unorm8(ga[m][bj].x), a1 = un_unorm8(ga[m][bj].y), b0 = un_unorm8(gb[m][bj].x), b1 = un_unorm8(gb[m][bj].y);
#pragma unroll
                    for (int j = 0; j < 4; ++j) { acc[ai][bj][m][0][j] *= a0[j] * __builtin_amdgcn_rcpf(b0[j]); acc[ai][bj][m][1][j] *= a1[j] * __builtin_amdgcn_rcpf(b1[j]); } }
            asm volatile("" ::: "memory");
        }
    }
    __device__ __forceinline__ void operator()(f32x4 (&acc)[2][2][4][2], const Unit& u, int wr, int wc, int fr, int fq) const {
        EPI_OPAQUE
#pragma unroll
        for (int ai = 0; ai < 2; ++ai) {
            u32x2 gg[4][2];
#pragma unroll
            for (int m = 0; m < 4; ++m)
#pragma unroll
                for (int bj = 0; bj < 2; ++bj) { const int row = u.pm * 256 + ai * 128 + wr * 64 + m * 16 + fr, col = u.pn * 256 + bj * 128 + wc * 32 + 8 * fq;
                    gg[m][bj] = *(const u32x2*)((const unsigned char*)P + (size_t)row * ROWB + GATE_B0 + 2 * DM + col); }
            asm volatile("" ::: "memory");
#pragma unroll
            for (int m = 0; m < 4; ++m)
#pragma unroll
                for (int bj = 0; bj < 2; ++bj) { const int row = u.pm * 256 + ai * 128 + wr * 64 + m * 16 + fr, col = u.pn * 256 + bj * 128 + wc * 32 + 8 * fq;
                    const f32x4 g0 = un_unorm8(gg[m][bj].x) * (1.0f / 255.0f), g1 = un_unorm8(gg[m][bj].y) * (1.0f / 255.0f);
                    *(u32x4*)(MG + (size_t)row * DM + col) = pack8(acc[ai][bj][m][0] * g0, acc[ai][bj][m][1] * g1); }
            asm volatile("" ::: "memory");
        }
    }
};
struct EpiWo {
    static constexpr bool SEAMS = false, INIT = true; static constexpr int SEAM0 = -1, SEAM1 = -1;
    const float* basef; const bf16_t* baseb; bf16_t* HB;
    __device__ __forceinline__ void seam(f32x4 (&)[2][2][4][2], const Unit&, int, int, int, int, int) const {}
    __device__ __forceinline__ void init(f32x4 (&acc)[2][2][4][2], const Unit& u, int wr, int wc, int fr, int fq) const {
        EPI_OPAQUE
        if (basef) {
            EPI_ROWS_BEGIN EPI_COLS_BEGIN
                const size_t off = (size_t)row * DM + col;
                acc[ai][bj][m][0] = *(const f32x4*)(basef + off); acc[ai][bj][m][1] = *(const f32x4*)(basef + off + 4);
            EPI_END EPI_END
        } else {
            EPI_ROWS_BEGIN EPI_COLS_BEGIN
                unpack8(*(const u32x4*)(baseb + (size_t)row * DM + col), acc[ai][bj][m][0], acc[ai][bj][m][1]);
            EPI_END EPI_END
        }
    }
    __device__ __forceinline__ void operator()(f32x4 (&acc)[2][2][4][2], const Unit& u, int wr, int wc, int fr, int fq) const {
        EPI_OPAQUE
        EPI_ROWS_BEGIN EPI_COLS_BEGIN
            *(u32x4*)(HB + (size_t)row * DM + col) = pack8(acc[ai][bj][m][0], acc[ai][bj][m][1]);
        EPI_END EPI_END
    }
};
struct EpiGate {
    static constexpr bool SEAMS = false, INIT = false; static constexpr int SEAM0 = -1, SEAM1 = -1;
    const bf16_t* H1; const bf16_t* PLE; bf16_t* HB; float* ssq;
    __device__ __forceinline__ void seam(f32x4 (&)[2][2][4][2], const Unit&, int, int, int, int, int) const {}
    __device__ __forceinline__ void operator()(f32x4 (&acc)[2][2][4][2], const Unit& u, int wr, int wc, int fr, int fq) const {
        EPI_OPAQUE
        const int row0 = u.pm * 256 + wr * 64 + fr, col0 = u.pn * 256 + wc * 32 + 8 * fq;
        u32x4 hA[2][2], pA[2][2];
#define GATE_LOAD(r, b) do { const int row_ = row0 + ((r) >> 2) * 128 + ((r) & 3) * 16; _Pragma("unroll") for (int bj = 0; bj < 2; ++bj) { const size_t off_ = (size_t)row_ * DM + col0 + bj * 128; \
            hA[b][bj] = *(const u32x4*)(H1 + off_); pA[b][bj] = *(const u32x4*)(PLE + off_); } } while (0)
        GATE_LOAD(0, 0);
#pragma unroll
        for (int r = 0; r < 8; ++r) {
            const int ai = r >> 2, m = r & 3, b = r & 1;
            if (r + 1 < 8) GATE_LOAD(r + 1, (r + 1) & 1);
            const int row = row0 + ai * 128 + m * 16;
            float ss = 0.f;
#pragma unroll
            for (int bj = 0; bj < 2; ++bj) {
                const size_t off = (size_t)row * DM + col0 + bj * 128;
                f32x4 p0, p1, o0, o1; unpack8(pA[b][bj], p0, p1); unpack8(hA[b][bj], o0, o1);
#pragma unroll
                for (int j = 0; j < 4; ++j) { o0[j] += sigmoid_f(acc[ai][bj][m][0][j]) * p0[j]; o1[j] += sigmoid_f(acc[ai][bj][m][1][j]) * p1[j]; }
                *(u32x4*)(HB + off) = pack8(o0, o1);
#pragma unroll
                for (int j = 0; j < 4; ++j) ss += o0[j] * o0[j] + o1[j] * o1[j];
            }
            ss += __shfl_xor(ss, 16); ss += __shfl_xor(ss, 32);
            if (fq == 0) atomicAdd(ssq + row, ss);
            asm volatile("" ::: "memory");
        }
#undef GATE_LOAD
    }
};

struct Args { const float* in[16]; float* out; unsigned char* ws; int ph_lo, ph_hi; };
enum { I_X = 0, I_P, I_NG, I_WIN, I_CAW, I_PW, I_PS, I_CCW, I_CCB, I_LNG, I_LNB, I_WBO, I_WO, I_WPG, I_WPP, I_FNG };

__device__ __forceinline__ void transpose_item(const float* __restrict__ W, int N, bf16_t* __restrict__ WT, int ldT, int k0, int n0, const float* __restrict__ kscale, LAS float* scr, int lane, int d0 = -1) {
    if (d0 < 0) d0 = n0;
    const int r = lane >> 4, c4 = lane & 15;
    f32x4 v[16]; float ks[16];
#pragma unroll
    for (int i = 0; i < 16; ++i) { const int kk = 4 * i + r; v[i] = __builtin_nontemporal_load((const f32x4*)(W + (size_t)(k0 + kk) * N + n0 + 4 * c4)); ks[i] = kscale ? kscale[k0 + kk] : 1.0f; }
    asm volatile("" ::: "memory");
#pragma unroll
    for (int i = 0; i < 16; ++i) { const int kk = 4 * i + r; const f32x4 w = v[i] * ks[i];
        LAS float* sp = scr + kk * 65 + 4 * c4; sp[0] = w[0]; sp[1] = w[1]; sp[2] = w[2]; sp[3] = w[3]; }
    asm volatile("s_waitcnt lgkmcnt(0)" ::: "memory");
    const int c = lane & 7;
#pragma unroll
    for (int j = 0; j < 8; ++j) { const int nn = (lane >> 3) + 8 * j; const LAS float* s = scr + (8 * c) * 65 + nn;
        u32x4 o; o.x = cvt_pk_bf16(s[0 * 65], s[1 * 65]); o.y = cvt_pk_bf16(s[2 * 65], s[3 * 65]); o.z = cvt_pk_bf16(s[4 * 65], s[5 * 65]); o.w = cvt_pk_bf16(s[6 * 65], s[7 * 65]);
        *(u32x4*)(WT + (size_t)(d0 + nn) * ldT + k0 + 8 * c) = o; }
    asm volatile("s_waitcnt lgkmcnt(0)" ::: "memory");
}
__device__ __forceinline__ float wave_sum(float v) {
#pragma unroll
    for (int o = 1; o < 64; o <<= 1) v += __shfl_xor(v, o);
    return v;
}
__device__ __forceinline__ void p0_prologue(const Args& a, LAS unsigned char* lds) {
    int tid = threadIdx.x; asm volatile("" : "+v"(tid));
    const int lane = tid & 63, wave = __builtin_amdgcn_readfirstlane(tid >> 6);
    LAS float* scr = (LAS float*)(lds + wave * 16640);
    const int gw = blockIdx.x * 8 + wave, NGW = gridDim.x * 8;
    unsigned char* ws = a.ws;
    constexpr int I_IN = 32 * 240, I_BO = 3 * 16 * 32, I_O = 32 * 32, I_G = 32 * 32, I_PP = 4 * 32, I_PL = 4 * 16;
    constexpr int PER_LAYER = I_IN + I_BO + I_O + I_G + I_PP + I_PL;
    for (int it = gw; it < DEPTH * PER_LAYER; it += NGW) {
        const int l = it / PER_LAYER; int r = it % PER_LAYER;
        if (r < I_IN) { const int kb = r / 240, nb = r % 240;
            const int c0 = 64 * nb, sl = c0 >> 10, e = c0 & 1023, pr = (e >> 7) * 256 + (e & 127); int d0 = c0;
            if (sl == 0) d0 = pr; else if (sl == 2) d0 = pr + 128; else if (sl == 1) d0 = 2048 + pr; else if (sl == 3) d0 = 2048 + pr + 128;
            else if (sl == 4) d0 = 4096 + e; else if (sl == 5) d0 = 5120 + e; else if (sl == 6) d0 = 6144 + pr; else if (sl == 7) d0 = 6144 + pr + 128; else if (sl == 8) d0 = 8192 + e;
            transpose_item(a.in[I_WIN] + (size_t)l * DM * NC, NC, (bf16_t*)(ws + WS_WI + l * SZ_WI), DM, 64 * kb, c0, a.in[I_NG] + l * DM, scr, lane, d0); continue; }
        r -= I_IN;
        if (r < I_BO) { const int n = r / 512, q = r % 512, kb = q / 32, nb = q % 32;
            transpose_item(a.in[I_WBO] + ((size_t)l * 3 + n) * EW * DM, DM, (bf16_t*)(ws + WS_WB + l * SZ_WB) + n * EW, YW, 64 * kb, 64 * nb, nullptr, scr, lane); continue; }
        r -= I_BO;
        if (r < I_O) { const int kb = r / 32, nb = r % 32;
            transpose_item(a.in[I_WO] + (size_t)l * DM * DM, DM, (bf16_t*)(ws + WS_WO + l * SZ_WO), DM, 64 * kb, 64 * nb, nullptr, scr, lane); continue; }
        r -= I_O;
        if (r < I_G) { const int kb = r / 32, nb = r % 32;
            transpose_item(a.in[I_WPG] + (size_t)l * DM * DM, DM, (bf16_t*)(ws + WS_WG + l * SZ_WO), DM, 64 * kb, 64 * nb, nullptr, scr, lane); continue; }
        r -= I_G;
        if (r < I_PP) { const int kb = r / 32, nb = r % 32;
            transpose_item(a.in[I_WPP] + (size_t)l * PD * DM, DM, (bf16_t*)(ws + WS_WP + l * SZ_WP), PD, 64 * kb, 64 * nb, nullptr, scr, lane); continue; }
        r -= I_PP;
        { const int gq = r / 16, q = r % 16, kb = q / 4, nb = q % 4;
            transpose_item(a.in[I_PW] + ((size_t)l * 4 + gq) * 256 * 256, 256, (bf16_t*)(ws + WS_PW + l * SZ_PW) + (size_t)gq * 256 * 256, 256, 64 * kb, 64 * nb, nullptr, scr, lane); }
    }
    float* ssq = (float*)(ws + WS_SSQ);
    bf16_t* hb0 = (bf16_t*)(ws + WS_HB0);
    for (int mrow = gw; mrow < MTOK; mrow += NGW) {
        const f32x4* xr = (const f32x4*)(a.in[I_X] + (size_t)mrow * DM) + lane;
        u32x2* o8 = (u32x2*)(hb0 + (size_t)mrow * DM) + lane;
        float s = 0.f; f32x4 xv[8];
#pragma unroll
        for (int j = 0; j < 8; ++j) xv[j] = __builtin_nontemporal_load(xr + 64 * j);
        asm volatile("" ::: "memory");
#pragma unroll
        for (int j = 0; j < 8; ++j) { const f32x4 v = xv[j]; s += (v[0] * v[0] + v[1] * v[1]) + (v[2] * v[2] + v[3] * v[3]);
            u32x2 w; w.x = cvt_pk_bf16(v[0], v[1]); w.y = cvt_pk_bf16(v[2], v[3]); o8[64 * j] = w; }
        s = wave_sum(s);
        if (lane == 0) { ssq[mrow] = s; ssq[MTOK + mrow] = 0.f; ssq[2 * MTOK + mrow] = 0.f; }
    }
    {
        const f32x4* ps = (const f32x4*)a.in[I_P]; u32x2* pd = (u32x2*)(ws + WS_PB);
        const size_t n4 = (size_t)DEPTH * MTOK * PD / 4, stride = (size_t)gridDim.x * 512;
        size_t i = (size_t)blockIdx.x * 512 + tid;
        for (; i + 3 * stride < n4; i += 4 * stride) { f32x4 v[4];
#pragma unroll
            for (int q = 0; q < 4; ++q) v[q] = __builtin_nontemporal_load(ps + i + q * stride);
            asm volatile("" ::: "memory");
#pragma unroll
            for (int q = 0; q < 4; ++q) { u32x2 w; w.x = cvt_pk_bf16(v[q][0], v[q][1]); w.y = cvt_pk_bf16(v[q][2], v[q][3]); pd[i + q * stride] = w; } }
        for (; i < n4; i += stride) { const f32x4 v = ps[i]; u32x2 w; w.x = cvt_pk_bf16(v[0], v[1]); w.y = cvt_pk_bf16(v[2], v[3]); pd[i] = w; }
    }
}

constexpr int TT = 16;
template <int H, int Q> __device__ __forceinline__ void red_one(float (&x)[2 * TT], bool up) { const float a = x[Q + H], b = x[Q]; const float keep = up ? a : b, send = up ? b : a; x[Q] = keep + __shfl_xor(send, H); }
template <int H, int... Q> __device__ __forceinline__ void red_step(float (&x)[2 * TT], int lane, std::integer_sequence<int, Q...>) { const bool up = (lane & H) != 0; (red_one<H, Q>(x, up), ...); }
__device__ __forceinline__ float wave_reduce32(float (&x)[2 * TT], int lane) {
    static_assert(TT == 16, "reduce written for 32 values");
    red_step<16>(x, lane, std::make_integer_sequence<int, 16>{});
    red_step<8>(x, lane, std::make_integer_sequence<int, 8>{});
    red_step<4>(x, lane, std::make_integer_sequence<int, 4>{});
    red_step<2>(x, lane, std::make_integer_sequence<int, 2>{});
    red_step<1>(x, lane, std::make_integer_sequence<int, 1>{});
    return x[0] + __shfl_xor(x[0], 32);
}
template <int W>
__device__ __forceinline__ void pool_branch(const bf16_t* __restrict__ Pb, bf16_t* __restrict__ out, bool first) {
    unsigned raw[W - 1 + TT];
#pragma unroll
    for (int j = 0; j < W - 1 + TT; ++j) { const int off = j - (W - 1); const int offc = (off < 0 && first) ? 0 : off;
        unsigned r = *(const unsigned*)(Pb + (ptrdiff_t)offc * NCO); if (off < 0 && first) r = 0u; raw[j] = r; }
    asm volatile("" ::: "memory");
    f32x2 S = (f32x2){0.f, 0.f};
#pragma unroll
    for (int j = 0; j < W - 1; ++j) S += un2(raw[j]);
#pragma unroll
    for (int i = 0; i < TT; ++i) {
        const f32x2 ui = un2(raw[i + W - 1]);
        S += ui;
        const float inv = (first && (i + 1 < W)) ? 1.0f / (float)(i + 1) : 1.0f / (float)W;
        st2(out + (size_t)i * EW, S * inv - ui);
        S -= un2(raw[i]);
    }
}
constexpr int CSTEPS = TT + 30;
template <int NDEAD, int B>
__device__ __forceinline__ void conv31_load(const bf16_t* __restrict__ Pt, unsigned (&cv)[8]) {
#pragma unroll
    for (int q = 0; q < 8; ++q) { const int JJ = 8 * B + q; if (JJ >= NDEAD && JJ < CSTEPS) cv[q] = *(const unsigned*)(Pt + (ptrdiff_t)(JJ - 30) * NCO + OV); }
}
template <int NDEAD, int B>
__device__ __forceinline__ void conv31_comp(const unsigned (&cv)[8], const f32x2 (&wk)[31], f32x2 (&acc)[TT]) {
#pragma unroll
    for (int q = 0; q < 8; ++q) { const int JJ = 8 * B + q; if (JJ >= NDEAD && JJ < CSTEPS) { const f32x2 v = un2(cv[q]);
#pragma unroll
        for (int i = 0; i < TT; ++i) { const int k = JJ - i; if (k >= 0 && k <= 30) acc[i] += wk[k] * v; } } }
}
#define MIX_ISSUED() asm volatile("" ::: "memory")
template <int NDEAD>
__device__ __forceinline__ void conv31_all(const bf16_t* __restrict__ Pt, const f32x2 (&wk)[31], f32x2 (&acc)[TT]) {
    static_assert(CSTEPS <= 48, "six batches of eight steps");
    unsigned cA[8], cB[8];
    conv31_load<NDEAD, 0>(Pt, cA); conv31_load<NDEAD, 1>(Pt, cB); MIX_ISSUED();
    conv31_comp<NDEAD, 0>(cA, wk, acc); conv31_load<NDEAD, 2>(Pt, cA); MIX_ISSUED();
    conv31_comp<NDEAD, 1>(cB, wk, acc); conv31_load<NDEAD, 3>(Pt, cB); MIX_ISSUED();
    conv31_comp<NDEAD, 2>(cA, wk, acc); conv31_load<NDEAD, 4>(Pt, cA); MIX_ISSUED();
    conv31_comp<NDEAD, 3>(cB, wk, acc); conv31_load<NDEAD, 5>(Pt, cB); MIX_ISSUED();
    conv31_comp<NDEAD, 4>(cA, wk, acc);
    conv31_comp<NDEAD, 5>(cB, wk, acc);
}

__device__ __forceinline__ void mixer_phase(const Args& a, int l, LAS unsigned char* lds, int tile0, int tstride, int tend) {
    int tid = threadIdx.x; asm volatile("" : "+v"(tid));
    const int lane = tid & 63, wave = __builtin_amdgcn_readfirstlane(tid >> 6);
    const int e0 = 2 * tid;
    const bf16_t* P = (const bf16_t*)(a.ws + WS_PROJ);
    bf16_t* Y = (bf16_t*)(a.ws + WS_Y);
    bf16_t* PO = (bf16_t*)(a.ws + WS_POOL);
    LAS float* red = (LAS float*)lds;
    LAS float* fin = (LAS float*)(lds + 1024);
    for (int ti = tile0; ti < tend; ti += tstride) {
        const int t0 = ti * TT, s0 = t0 % SEQ; const bool first = (s0 == 0);
        const bf16_t* Pt = P + (size_t)t0 * NCO + e0;
        {
            const float* cw = a.in[I_CAW] + (size_t)l * 3 * EW + e0;
            const f32x2 w0 = *(const f32x2*)cw, w1 = *(const f32x2*)(cw + EW), w2 = *(const f32x2*)(cw + 2 * EW);
            f32x2 q2 = (f32x2){0.f, 0.f}, q1 = (f32x2){0.f, 0.f};
            if (!first) { q2 = ld2(Pt - 2 * (ptrdiff_t)NCO + OQ); q1 = ld2(Pt - (ptrdiff_t)NCO + OQ); }
            unsigned rA[TT][2];
#pragma unroll
            for (int i = 0; i < TT; ++i) { const bf16_t* pr = Pt + (size_t)i * NCO; rA[i][0] = *(const unsigned*)(pr + OQ); rA[i][1] = *(const unsigned*)(pr + OAB); }
            MIX_ISSUED();
#pragma unroll
            for (int i = 0; i < TT; ++i) {
                const f32x2 q = un2(rA[i][0]), abz = un2(rA[i][1]);
                const f32x2 cv = w0 * q2 + w1 * q1 + w2 * q;
                st2(Y + (size_t)(t0 + i) * YW + e0, abz * cv);
                q2 = q1; q1 = q;
            }
        }
        asm volatile("" ::: "memory");
        {
            const bf16_t* Pb = Pt + OBIN; bf16_t* po = PO + (size_t)t0 * EW + e0;
            const int grp = wave >> 1;
            if (grp == 0) pool_branch<2>(Pb, po, first);
            else if (grp == 1) pool_branch<4>(Pb, po, first);
            else if (grp == 2) pool_branch<8>(Pb, po, first);
            else pool_branch<16>(Pb, po, first);
        }
        asm volatile("" ::: "memory");
        {
            const float* cw = a.in[I_CCW] + (size_t)l * 31 * EW + e0;
            f32x2 wk[31];
#pragma unroll
            for (int k = 0; k < 31; ++k) wk[k] = *(const f32x2*)(cw + (size_t)k * EW);
            const f32x2 bias = *(const f32x2*)(a.in[I_CCB] + (size_t)l * EW + e0);
            f32x2 acc[TT];
#pragma unroll
            for (int i = 0; i < TT; ++i) acc[i] = bias;
            if (s0 == 0) conv31_all<30>(Pt, wk, acc);
            else if (s0 == TT) conv31_all<30 - TT>(Pt, wk, acc);
            else conv31_all<0>(Pt, wk, acc);
            float st[2 * TT];
#pragma unroll
            for (int i = 0; i < TT; ++i) { st[2 * i] = acc[i].x + acc[i].y; st[2 * i + 1] = acc[i].x * acc[i].x + acc[i].y * acc[i].y; }
            const float tot = wave_reduce32(st, lane);
            __syncthreads();
            if (lane < 32) red[wave * 32 + lane] = tot;
            __syncthreads();
            if (tid < 32) { float s = 0.f;
#pragma unroll
                for (int w = 0; w < 8; ++w) s += red[w * 32 + tid];
                fin[tid] = s; }
            __syncthreads();
            const f32x2 lg = *(const f32x2*)(a.in[I_LNG] + (size_t)l * EW + e0), lb = *(const f32x2*)(a.in[I_LNB] + (size_t)l * EW + e0);
            unsigned rz[TT];
#pragma unroll
            for (int i = 0; i < TT; ++i) rz[i] = *(const unsigned*)(Pt + (size_t)i * NCO + OCZ);
            MIX_ISSUED();
#pragma unroll
            for (int i = 0; i < TT; ++i) {
                const float mean = fin[2 * i] * (1.0f / EW);
                const float var = fmaxf(fin[2 * i + 1] * (1.0f / EW) - mean * mean, 0.f);
                const float rstd = __builtin_amdgcn_rsqf(var + LN_EPS);
                f32x2 y = (acc[i] - mean) * rstd * lg + lb;
                y.x = silu_f(y.x); y.y = silu_f(y.y);
                st2(Y + (size_t)(t0 + i) * YW + 2 * EW + e0, y * un2(rz[i]));
            }
        }
    }
}

__device__ __forceinline__ void final_phase(const Args& a) {
    int tid = threadIdx.x; asm volatile("" : "+v"(tid));
    const int lane = tid & 63, wave = tid >> 6;
    const int gw = blockIdx.x * 8 + wave, NGW = gridDim.x * 8;
    const float* ssq = (const float*)(a.ws + WS_SSQ) + 2 * MTOK;
    const bf16_t* HB = (const bf16_t*)(a.ws + WS_HB0);
    const f32x4* fg = (const f32x4*)a.in[I_FNG] + 2 * lane;
    for (int mrow = gw; mrow < MTOK; mrow += NGW) {
        const float rs = __builtin_amdgcn_rsqf(ssq[mrow] * (1.0f / DM) + RMS_EPS);
        const u32x4* hr = (const u32x4*)(HB + (size_t)mrow * DM) + lane; f32x4* orow = (f32x4*)(a.out + (size_t)mrow * DM) + 2 * lane;
        u32x4 hv[4];
#pragma unroll
        for (int j = 0; j < 4; ++j) hv[j] = hr[64 * j];
        asm volatile("" ::: "memory");
#pragma unroll
        for (int j = 0; j < 4; ++j) { f32x4 h0, h1; unpack8(hv[j], h0, h1); orow[128 * j] = h0 * rs * fg[128 * j]; orow[128 * j + 1] = h1 * rs * fg[128 * j + 1]; }
    }
}

#define XB_TMO      128
#define XB_XCNT(j)  (256  + 64 * (j))
#define XB_XSUB(j)  (1280 + 64 * (j))
#define XB_XGEN(j)  (2304 + 64 * (j))
#define XB_TOP      3328
#define XB_TOPGEN   3392
#define XCD_BAR_WORDS 3456
#define XB_SPIN_CAP (1u << 20)
__device__ __forceinline__ unsigned xb_ld(unsigned* p)              { return __hip_atomic_load(p, __ATOMIC_RELAXED, __HIP_MEMORY_SCOPE_AGENT); }
__device__ __forceinline__ unsigned xb_add(unsigned* p, unsigned v) { return __hip_atomic_fetch_add(p, v, __ATOMIC_RELAXED, __HIP_MEMORY_SCOPE_AGENT); }
__device__ __forceinline__ unsigned xb_xcc_id() { return (unsigned)__builtin_amdgcn_s_getreg((3 << 11) | 20) & 0xFu; }
#define XB_SPIN(cond, bar) do { unsigned _sp = 0; while (cond) { __builtin_amdgcn_s_sleep(1); \
    if ((++_sp & 255u) == 0u) { if (xb_ld(&(bar)[XB_TMO])) break; if (_sp > XB_SPIN_CAP) { atomicAdd(&(bar)[XB_TMO], 1u); break; } } } } while (0)
struct XcdBarrier { unsigned* bar; unsigned x; volatile LAS unsigned* st; };
__device__ __forceinline__ XcdBarrier xcd_barrier_post(unsigned* bar, volatile LAS unsigned* st) {
    XcdBarrier b; b.bar = bar; b.x = xb_xcc_id(); b.st = st;
    if (threadIdx.x == 0) st[2] = xb_add(&bar[XB_XCNT(b.x)], 1u);
    return b;
}
__device__ __forceinline__ void xcd_barrier_complete(unsigned* bar, unsigned x, unsigned& nloc, unsigned& nx) {
    const unsigned G = gridDim.x * gridDim.y * gridDim.z;
    unsigned sum, cnt, mine, sp = 0u;
    for (;;) {
        sum = 0u; cnt = 0u; mine = 0u;
#pragma unroll
        for (unsigned j = 0; j < 16; ++j) { const unsigned c = xb_ld(&bar[XB_XCNT(j)]); sum += c; cnt += (c > 0u) ? 1u : 0u; mine = (j == x) ? c : mine; }
        if (sum == G) break;
        __builtin_amdgcn_s_sleep(1);
        if ((++sp & 255u) == 0u) { if (xb_ld(&bar[XB_TMO])) break; if (sp > XB_SPIN_CAP) { atomicAdd(&bar[XB_TMO], 1u); break; } }
    }
    nloc = mine > 0u ? mine : 1u; nx = cnt > 0u ? cnt : 1u;
}
__device__ __forceinline__ void xcd_barrier(const XcdBarrier& b, bool local = false) {
    asm volatile("s_waitcnt vmcnt(0)" ::: "memory");
    __syncthreads();
    if (threadIdx.x == 0) {
        unsigned* bar = b.bar;
        __builtin_amdgcn_s_waitcnt(0);
        unsigned nloc = b.st[0], nx = b.st[1];
        if (nloc == 0u) { xcd_barrier_complete(bar, b.x, nloc, nx); b.st[0] = nloc; b.st[1] = nx; }
        const unsigned old = xb_add(&bar[XB_XSUB(b.x)], 1u);
        const unsigned gen = old / nloc;
        if (old + 1u == (gen + 1u) * nloc) {
            if (!local) {
            __builtin_amdgcn_fence(__ATOMIC_RELEASE, "agent");
            asm volatile("s_waitcnt vmcnt(0)" ::: "memory");
            const unsigned og = xb_add(&bar[XB_TOP], 1u);
            const unsigned tg = og / nx;
            if (og + 1u == (tg + 1u) * nx) xb_add(&bar[XB_TOPGEN], 1u);
            else XB_SPIN(xb_ld(&bar[XB_TOPGEN]) == tg, bar);
            }
            __builtin_amdgcn_fence(__ATOMIC_ACQUIRE, "agent");
            xb_add(&bar[XB_XGEN(b.x)], 1u);
            asm volatile("s_waitcnt vmcnt(0)" ::: "memory");
        } else {
            XB_SPIN(xb_ld(&bar[XB_XGEN(b.x)]) == gen, bar);
            __builtin_amdgcn_fence(__ATOMIC_ACQUIRE, "agent");
            asm volatile("s_waitcnt vmcnt(0)" ::: "memory");
        }
    }
    __syncthreads();
}

struct EpiSplit {
    static constexpr bool SEAMS = false, INIT = false; static constexpr int SEAM0 = -1, SEAM1 = -1;
    bf16_t* P; const float* ssq; int pn0; float* part; XcdBarrier xb; int lx, lr;
    __device__ __forceinline__ void seam(f32x4 (&)[2][2][4][2], const Unit&, int, int, int, int, int) const {}
    __device__ __forceinline__ void operator()(f32x4 (&acc)[2][2][4][2], const Unit& u, int wr, int wc, int fr, int fq) const {
        EPI_OPAQUE
        const int tid = (wr * 4 + wc) * 64 + fq * 16 + fr;
        f32x4* mine = (f32x4*)part + (size_t)(lx * 32 + lr) * 16 * 512 + tid;
        const f32x4* theirs = (const f32x4*)part + (size_t)(lx * 32 + (lr ^ 16)) * 16 * 512 + tid;
#pragma unroll
        for (int bj = 0; bj < 2; ++bj)
#pragma unroll
            for (int m = 0; m < 4; ++m)
#pragma unroll
                for (int n = 0; n < 2; ++n) mine[(size_t)((bj * 4 + m) * 2 + n) * 512] = acc[1][bj][m][n];
        xcd_barrier(xb, true);
        f32x4 pv[2][4][2];
#pragma unroll
        for (int bj = 0; bj < 2; ++bj)
#pragma unroll
            for (int m = 0; m < 4; ++m)
#pragma unroll
                for (int n = 0; n < 2; ++n) pv[bj][m][n] = theirs[(size_t)((bj * 4 + m) * 2 + n) * 512];
        const int rbase = u.pm * 256 + u.half * 128 + wr * 64 + fr;
        float rsv[4];
#pragma unroll
        for (int m = 0; m < 4; ++m) rsv[m] = ssq[rbase + m * 16];
        asm volatile("" ::: "memory");
        const int gbase = (u.pn + pn0 - 36) * 256;
#pragma unroll
        for (int m = 0; m < 4; ++m) {
            const int row = rbase + m * 16;
            const float rs = __builtin_amdgcn_rsqf(rsv[m] * (1.0f / DM) + RMS_EPS);
#pragma unroll
            for (int bj = 0; bj < 2; ++bj) { const int gcol = gbase + bj * 128 + wc * 32 + 8 * fq;
                f32x4 v0 = (acc[0][bj][m][0] + pv[bj][m][0]) * rs, v1 = (acc[0][bj][m][1] + pv[bj][m][1]) * rs;
#pragma unroll
                for (int j = 0; j < 4; ++j) { v0[j] = sigmoid_f(v0[j]); v1[j] = sigmoid_f(v1[j]); }
                u32x2 w; w.x = pk_unorm8(v0); w.y = pk_unorm8(v1);
                *(u32x2*)((unsigned char*)P + (size_t)row * ROWB + GATE_B0 + gcol) = w;
            }
        }
    }
};

__global__ void __launch_bounds__(512, 2) fwd_megakernel(Args a) {
    extern __shared__ __attribute__((aligned(16))) unsigned char lds_raw[];
    LAS unsigned char* lds = (LAS unsigned char*)lds_raw;
    cg::grid_group grid = cg::this_grid();
    unsigned char* ws = a.ws;
    const int lo = a.ph_lo, hi = a.ph_hi;
#ifndef PH_MASK
#define PH_MASK 0xffff
#endif
#define KIND(b) ((PH_MASK >> (b)) & 1)
#define IN(k) (lo <= (k) && (k) < hi)
#define SEAM(k) do { if (IN(k) && IN((k) + 1)) { if (lo < 0) grid.sync(); else xcd_barrier(xb); } } while (0)
#define SEAML(k) do { if (IN(k) && IN((k) + 1)) xcd_barrier(xb, lx >= 0); } while (0)
    volatile LAS unsigned* xst = (volatile LAS unsigned*)(lds + LDS_BYTES - 16);
    if (threadIdx.x < 4) xst[threadIdx.x] = 0u;
    __syncthreads();
    XcdBarrier xb = xcd_barrier_post((unsigned*)(ws + WS_BAR), xst);
    float* ssq = (float*)(ws + WS_SSQ);
    bf16_t* hb0 = (bf16_t*)(ws + WS_HB0); bf16_t* hb1 = (bf16_t*)(ws + WS_HB1);
    bf16_t* PROJ = (bf16_t*)(ws + WS_PROJ); bf16_t* Y = (bf16_t*)(ws + WS_Y); bf16_t* MG = (bf16_t*)(ws + WS_MG);

    if (IN(0) && KIND(0)) { p0_prologue(a, lds); __syncthreads(); }
    SEAM(0);
    int lx = -1, lr = 0;
    if (IN(0) && IN(1) && gridDim.x == 256u && xb.x < 8u) {
        unsigned* bar = (unsigned*)(ws + WS_BAR); bool even = true;
#pragma unroll
        for (unsigned j = 0; j < 16; ++j) { const unsigned cj = xb_ld(&bar[XB_XCNT(j)]); even = even && (cj == (j < 8u ? 32u : 0u)); }
        const unsigned rank = xst[2];
        if (even && rank < 32u) { lx = (int)xb.x; lr = (int)rank; }
    }
    lx = __builtin_amdgcn_readfirstlane(lx); lr = __builtin_amdgcn_readfirstlane(lr);
    for (int l = 0; l < DEPTH; ++l) {
        const int pb = 1 + 6 * l;
        if (IN(pb) && KIND(2)) {
            constexpr int TFULL = NC / 256 - 4;
            { pg8::Gemm g{hb0, (const bf16_t*)(ws + WS_WI + l * SZ_WI), DM, DM, DM, MTOK / 256, TFULL, 0, lx, lr};
              EpiProj E{PROJ, ssq + l * MTOK, 0};
              pg8::gemm_phase<EpiProj>(lds, g, E); }
            if (lx >= 0) {
              pg8::Gemm g{hb0, (const bf16_t*)(ws + WS_WI + l * SZ_WI) + (size_t)TFULL * 256 * DM, DM, DM, DM / 2, MTOK / 256, 4, 0, lx, lr};
              EpiSplit E{PROJ, ssq + l * MTOK, TFULL, (float*)(ws + WS_H), xb, lx, lr};
              pg8::gemm_phase<EpiSplit, pg8::SplitKOrder, 2>(lds, g, E);
            } else {
              pg8::Gemm g{hb0, (const bf16_t*)(ws + WS_WI + l * SZ_WI) + (size_t)TFULL * 256 * DM, DM, DM, DM, MTOK / 256, 4, 0, lx, lr};
              EpiProj E{PROJ, ssq + l * MTOK, TFULL};
              pg8::gemm_phase<EpiProj, pg8::HalfNOrder, 1>(lds, g, E); }
        }
        SEAM(pb);
        if (IN(pb + 1) && KIND(3)) {
            if (lx >= 0) mixer_phase(a, l, lds, lx * (MTOK / TT / 8) + lr, 32, (lx + 1) * (MTOK / TT / 8));
            else mixer_phase(a, l, lds, (int)blockIdx.x, (int)gridDim.x, MTOK / TT);
            __syncthreads(); }
        SEAML(pb + 1);
        if (IN(pb + 2) && KIND(4)) {
            pg8::Gemm g{(const bf16_t*)(ws + WS_POOL), (const bf16_t*)(ws + WS_PW + l * SZ_PW), EW, 256, 256, MTOK / 256, 4, 256, lx, lr};
            EpiPool E{Y, a.in[I_PS] + (size_t)l * EW, PROJ};
            pg8::gemm_phase<EpiPool>(lds, g, E);
            if (KIND(1)) {
                pg8::Gemm gq{(const bf16_t*)(ws + WS_PB + l * SZ_PB), (const bf16_t*)(ws + WS_WP + l * SZ_WP), PD, PD, PD, MTOK / 256, DM / 256, 0, lx, lr};
                EpiPlain Eq{(bf16_t*)(ws + WS_PLE + l * SZ_ACT), DM};
                pg8::gemm_phase<EpiPlain, pg8::IdleOrder>(lds, gq, Eq);
            }
        }
        SEAML(pb + 2);
        if (IN(pb + 3) && KIND(5)) {
            pg8::Gemm g{Y, (const bf16_t*)(ws + WS_WB + l * SZ_WB), YW, YW, YW, MTOK / 256, DM / 256, 0, lx, lr};
            EpiMerge E{PROJ, MG};
            pg8::gemm_phase<EpiMerge>(lds, g, E);
        }
        SEAML(pb + 3);
        if (IN(pb + 4) && KIND(6)) {
            pg8::Gemm g{MG, (const bf16_t*)(ws + WS_WO + l * SZ_WO), DM, DM, DM, MTOK / 256, DM / 256, 0, lx, lr};
            EpiWo E{l == 0 ? a.in[I_X] : (const float*)nullptr, hb0, hb1};
            pg8::gemm_phase<EpiWo>(lds, g, E);
        }
        SEAML(pb + 4);
        if (IN(pb + 5) && KIND(7)) {
            pg8::Gemm g{hb1, (const bf16_t*)(ws + WS_WG + l * SZ_WO), DM, DM, DM, MTOK / 256, DM / 256, 0, lx, lr};
            EpiGate E{hb1, (const bf16_t*)(ws + WS_PLE + l * SZ_ACT), hb0, ssq + (l + 1) * MTOK};
            pg8::gemm_phase<EpiGate>(lds, g, E);
        }
        SEAM(pb + 5);
    }
    if (IN(13) && KIND(8)) final_phase(a);
#undef IN
#undef SEAM
}

#ifndef MK_NLAUNCH
#define MK_NLAUNCH 1
#endif
extern "C" void kernel_launch(void* const* d_in, const int* in_sizes, int n_in, void* d_out, int out_size, void* d_ws, size_t ws_size, hipStream_t stream) {
    static int grid = 0;
    if (grid == 0) {
        if (n_in != 16 || ws_size < WS_END) { fprintf(stderr, "kernel_launch: expected 16 inputs and >= %zu bytes of workspace (got %d, %zu)\n", (size_t)WS_END, n_in, ws_size); grid = -1; return; }
        int dev = 0, cus = 0, per_cu = 0;
        hipGetDevice(&dev);
        hipDeviceGetAttribute(&cus, hipDeviceAttributeMultiprocessorCount, dev);
        if (hipFuncSetAttribute((const void*)fwd_megakernel, hipFuncAttributeMaxDynamicSharedMemorySize, LDS_BYTES) != hipSuccess) { fprintf(stderr, "kernel_launch: hipFuncSetAttribute failed\n"); grid = -1; return; }
        if (hipOccupancyMaxActiveBlocksPerMultiprocessor(&per_cu, (const void*)fwd_megakernel, 512, LDS_BYTES) != hipSuccess || per_cu < 1) { fprintf(stderr, "kernel_launch: occupancy query says %d\n", per_cu); per_cu = 1; }
        (void)hipGetLastError();
        grid = cus * 1;
        fprintf(stderr, "kernel_launch: grid %d (cus %d, per_cu %d)\n", grid, cus, per_cu);
    }
    if (grid < 0) return;
    if (hipMemsetAsync((char*)d_ws + WS_BAR, 0, XCD_BAR_WORDS * 4, stream) != hipSuccess) { fprintf(stderr, "kernel_launch: memset of the barrier words failed\n"); return; }
    Args a{};
    for (int i = 0; i < 16; ++i) a.in[i] = (const float*)d_in[i];
    a.out = (float*)d_out; a.ws = (unsigned char*)d_ws;
#if MK_NLAUNCH == 1
    a.ph_lo = 0; a.ph_hi = 14;
    { void* args[] = {&a}; hipError_t e = hipLaunchCooperativeKernel((const void*)fwd_megakernel, dim3(grid), dim3(512), args, LDS_BYTES, stream);
      if (e != hipSuccess) fprintf(stderr, "cooperative launch failed: %s (grid %d)\n", hipGetErrorString(e), grid); }
#else
    for (int ph = 0; ph < 14; ++ph) { a.ph_lo = ph; a.ph_hi = ph + 1; void* args[] = {&a};
        hipError_t e = hipLaunchCooperativeKernel((const void*)fwd_megakernel, dim3(grid), dim3(512), args, LDS_BYTES, stream);
        if (e != hipSuccess) { fprintf(stderr, "launch %d failed: %s\n", ph, hipGetErrorString(e)); break; } }
#endif
}
```

```cpp
#include <hip/hip_runtime.h>
#include <hip/hip_cooperative_groups.h>
#include <cstdio>
#include <cstdint>
#include <utility>
namespace cg = cooperative_groups;

#define LAS __attribute__((address_space(3)))
typedef unsigned short bf16_t;
typedef short bf16x8 __attribute__((ext_vector_type(8)));
typedef float f32x4 __attribute__((ext_vector_type(4)));
typedef float f32x2 __attribute__((ext_vector_type(2)));
typedef unsigned u32x4 __attribute__((ext_vector_type(4)));
typedef unsigned u32x2 __attribute__((ext_vector_type(2)));

constexpr int MTOK = 8192, DM = 2048, EW = 1024, NC = 15360, PD = 256, SEQ = 2048, DEPTH = 2;
constexpr int YW = 3 * EW;
constexpr int NCO = 9 * EW;
constexpr int OQ = 0, OAB = EW, OBIN = 2 * EW, OBZ = 3 * EW, OV = 4 * EW, OCZ = 5 * EW;
constexpr int GATE_B0 = 12 * EW;
constexpr size_t ROWB = (size_t)NCO * 2;
constexpr float RMS_EPS = 1e-6f, LN_EPS = 1e-5f;

constexpr size_t WS_SSQ = 0;
constexpr size_t WS_BAR = 128 << 10;
constexpr size_t WS_WI = 1 << 20;
constexpr size_t SZ_WI = (size_t)NC * DM * 2;
constexpr size_t WS_WB = WS_WI + 2 * SZ_WI;
constexpr size_t SZ_WB = (size_t)DM * YW * 2;
constexpr size_t WS_WO = WS_WB + 2 * SZ_WB;
constexpr size_t SZ_WO = (size_t)DM * DM * 2;
constexpr size_t WS_WG = WS_WO + 2 * SZ_WO;
constexpr size_t WS_WP = WS_WG + 2 * SZ_WO;
constexpr size_t SZ_WP = (size_t)DM * PD * 2;
constexpr size_t WS_PW = WS_WP + 2 * SZ_WP;
constexpr size_t SZ_PW = (size_t)EW * 256 * 2;
constexpr size_t WS_PB = WS_PW + 2 * SZ_PW;
constexpr size_t SZ_PB = (size_t)MTOK * PD * 2;
constexpr size_t WS_PLE = WS_PB + 2 * SZ_PB;
constexpr size_t SZ_ACT = (size_t)MTOK * DM * 2;
constexpr size_t WS_HB0 = WS_PLE + 2 * SZ_ACT;
constexpr size_t WS_HB1 = WS_HB0 + SZ_ACT;
constexpr size_t WS_MG = WS_HB1 + SZ_ACT;
constexpr size_t WS_H = WS_MG + SZ_ACT;
constexpr size_t WS_PROJ = WS_H + 2 * SZ_ACT;
constexpr size_t WS_POOL = WS_PROJ + (size_t)MTOK * NC * 2;
constexpr size_t WS_Y = WS_POOL + (size_t)MTOK * EW * 2;
constexpr size_t WS_END = WS_Y + (size_t)MTOK * YW * 2;

constexpr int LDS_BYTES = 147456;

typedef __bf16 bf16x2_t __attribute__((ext_vector_type(2)));
__device__ __forceinline__ unsigned cvt_pk_bf16(float lo, float hi) { const bf16x2_t r = __builtin_convertvector((f32x2){lo, hi}, bf16x2_t); return __builtin_bit_cast(unsigned, r); }
__device__ __forceinline__ float bf_lo(unsigned u) { return __uint_as_float(u << 16); }
__device__ __forceinline__ float bf_hi(unsigned u) { return __uint_as_float(u & 0xffff0000u); }
__device__ __forceinline__ f32x2 ld2(const bf16_t* p) { const unsigned u = *(const unsigned*)p; return (f32x2){bf_lo(u), bf_hi(u)}; }
__device__ __forceinline__ f32x2 un2(unsigned u) { return (f32x2){bf_lo(u), bf_hi(u)}; }
__device__ __forceinline__ void st2(bf16_t* p, f32x2 v) { *(unsigned*)p = cvt_pk_bf16(v.x, v.y); }
__device__ __forceinline__ float sigmoid_f(float x) { return __builtin_amdgcn_rcpf(1.0f + __builtin_amdgcn_exp2f(-1.4426950409f * x)); }
__device__ __forceinline__ float silu_f(float x) { return x * sigmoid_f(x); }
__device__ __forceinline__ u32x4 pack8(f32x4 a, f32x4 b) { u32x4 w; w.x = cvt_pk_bf16(a[0], a[1]); w.y = cvt_pk_bf16(a[2], a[3]); w.z = cvt_pk_bf16(b[0], b[1]); w.w = cvt_pk_bf16(b[2], b[3]); return w; }
__device__ __forceinline__ void unpack8(u32x4 g, f32x4& a, f32x4& b) { a = (f32x4){bf_lo(g.x), bf_hi(g.x), bf_lo(g.y), bf_hi(g.y)}; b = (f32x4){bf_lo(g.z), bf_hi(g.z), bf_lo(g.w), bf_hi(g.w)}; }

__device__ __forceinline__ unsigned pk_unorm8(f32x4 v) { const unsigned b0 = (unsigned)(v[0] * 255.0f + 0.5f), b1 = (unsigned)(v[1] * 255.0f + 0.5f), b2 = (unsigned)(v[2] * 255.0f + 0.5f), b3 = (unsigned)(v[3] * 255.0f + 0.5f); return b0 | (b1 << 8) | (b2 << 16) | (b3 << 24); }
__device__ __forceinline__ f32x4 un_unorm8(unsigned w) { return (f32x4){fmaxf((float)(w & 255u), 0.5f), fmaxf((float)((w >> 8) & 255u), 0.5f), fmaxf((float)((w >> 16) & 255u), 0.5f), fmaxf((float)(w >> 24), 0.5f)}; }
namespace pg8 {
constexpr int BM = 256, BK = 64, HALF = 128, HTB = HALF * BK * 2, STAGE_BYTES = 8 * HTB, NXCD = 8, WGM = 8;
__host__ __device__ __forceinline__ int lds_byte(int r, int c) { const int st = (r >> 4) * 2 + (c >> 5), rr = r & 15, cc = c & 31, ob = rr * 64 + cc * 2; return st * 1024 + (ob ^ (((ob >> 9) & 1) << 5)); }
__host__ __device__ __forceinline__ void stage_rc(int b, int& R, int& C) { const int st = b / 1024, sb = b % 1024, swz = sb ^ (((sb >> 9) & 1) << 5); R = (st >> 1) * 16 + swz / 64; C = (st & 1) * 32 + (swz % 64) / 2; }
__host__ __device__ __forceinline__ int perm32(int rho) { const int n = rho >> 4, i = rho & 15; return 8 * (i >> 2) + 4 * n + (i & 3); }

struct Unit { int pm, pn, half; };
struct Gemm { const bf16_t* A; const bf16_t* Bt; int lda, ldb, K, nM, nN, a_pn_off, lx, lr; };

struct StaticOrder {
    int nM, nN, nwg, G, c, lx, lr;
    __device__ void init(int nM_, int nN_, int G_, int c_) { nM = nM_; nN = nN_; nwg = nM * nN; G = G_; c = c_; lx = -1; lr = 0; }
    __device__ void map(int L, Unit& u) const {
        int wgid = L; { const int q = nwg / NXCD, r = nwg % NXCD, xcd = wgid % NXCD, off = wgid / NXCD; wgid = (xcd < r ? xcd * (q + 1) : r * (q + 1) + (xcd - r) * q) + off; }
        const int nig = WGM * nN, gid = wgid / nig, fm = gid * WGM, gsz = (nM - fm) < WGM ? (nM - fm) : WGM;
        u.pm = fm + ((wgid % nig) % gsz); u.pn = (wgid % nig) / gsz; u.half = 0;
    }
    __device__ bool next(int i, Unit& u) const {
        if (lx >= 0) { const int pn = i * 8 + (lr >> 2); if (pn >= nN) return false; u.pm = 4 * lx + (lr & 3); u.pn = pn; u.half = 0; return true; }
        const long L = (long)i * G + c; if (L >= nwg) return false; map((int)L, u); return true; }
};

struct HalfNOrder : StaticOrder {
    __device__ bool next(int i, Unit& u) const {
        if (lx >= 0) { if (i > 0) return false; const int rr = lr >> 2; u.pm = 4 * lx + (lr & 3); u.pn = rr >> 1; u.half = 1 + (rr & 1); return u.pn < nN; }
        const long L = (long)i * G + c; if (L >= 2L * nwg) return false;
        const int lab = (int)(L & 7), idx = (int)(L >> 3), ppl = nM >> 3, r = idx / ppl;
        u.pm = lab * ppl + idx % ppl; u.pn = r >> 1; u.half = 1 + (r & 1); return true;
    }
};

struct IdleOrder : StaticOrder {
    static constexpr int PREV_TILES = (MTOK / 256) * (NC / 256);
    __device__ bool next(int i, Unit& u) const {
        if (lx >= 0) { if (lr < 16) return false; const int idx = i * 16 + (lr - 16); if (idx >= 4 * nN) return false; u.pm = 4 * lx + (idx & 3); u.pn = idx >> 2; u.half = 0; return true; }
        const int busy = G / 2;
        if (c < busy) return false;
        const long L = (long)i * (G - busy) + (c - busy); if (L >= nwg) return false; map((int)L, u); return true;
    }
};

template <class Epi, class Order = StaticOrder, bool HALFN = false>
__device__ __forceinline__ void gemm_phase(LAS unsigned char* lds, const Gemm g, const Epi& E) {
    int tid = threadIdx.x; asm volatile("" : "+v"(tid));
    const int wid = __builtin_amdgcn_readfirstlane(tid >> 6), lane = tid & 63, wr = wid >> 2, wc = wid & 3, fr = lane & 15, fq = lane >> 4;
    const int K = g.K, nt = K / BK;
    Order S; S.init(g.nM, g.nN, (int)gridDim.x, (int)blockIdx.x); S.lx = g.lx; S.lr = g.lr;
    unsigned voffA[2], voffB[2];
#pragma unroll
    for (int i = 0; i < 2; ++i) { int R, C; stage_rc(tid * 16 + i * 8192, R, C); const int Rb = (R & ~31) + perm32(R & 31);
        voffA[i] = (unsigned)(R * g.lda + C) * 2u; voffB[i] = (unsigned)(Rb * g.ldb + C) * 2u; }
    const size_t kstep = (size_t)(BK * 2);
    const size_t hstepA = (size_t)HALF * g.lda * 2, hstepB = (size_t)HALF * g.ldb * 2;
    const size_t tstepA = 2 * hstepA, tstepB = 2 * hstepB;
    const unsigned ldsw = (unsigned)wid * 1024u;
    const int aoff = lds_byte(wr * 64 + fr, fq * 8), boff = lds_byte(wc * 32 + fr, fq * 8);
#define PG8_SA(b, h) (((b) * 2 + (h)) * HTB)
#define PG8_SB(b, h) ((4 + (b) * 2 + (h)) * HTB)
#define PG8_STAGE(bufoff, gbase, voff) do { _Pragma("unroll") for (int _i = 0; _i < 2; ++_i) \
        __builtin_amdgcn_global_load_lds((const unsigned*)((const char*)(gbase) + (voff)[_i]), (LAS unsigned*)(lds + (bufoff) + ldsw + _i * 8192), 16, 0, 0); } while (0)
#define PG8_LDA(dst, b, h) do { _Pragma("unroll") for (int m = 0; m < 4; ++m) _Pragma("unroll") for (int k = 0; k < 2; ++k) dst[m][k] = *(const LAS bf16x8*)(lds + PG8_SA(b, h) + aoff + m * 2048 + k * 1024); } while (0)
#define PG8_LDB(dst, b, h) do { _Pragma("unroll") for (int n = 0; n < 2; ++n) _Pragma("unroll") for (int k = 0; k < 2; ++k) dst[n][k] = *(const LAS bf16x8*)(lds + PG8_SB(b, h) + boff + n * 2048 + k * 1024); } while (0)
#define PG8_MMA(ai, bj, At, Bt) do { __builtin_amdgcn_s_setprio(1); _Pragma("unroll") for (int m = 0; m < 4; ++m) _Pragma("unroll") for (int n = 0; n < 2; ++n) _Pragma("unroll") for (int k = 0; k < 2; ++k) \
        acc[ai][bj][m][n] = __builtin_amdgcn_mfma_f32_16x16x32_bf16(Bt[n][k], At[m][k], acc[ai][bj][m][n], 0, 0, 0); __builtin_amdgcn_s_setprio(0); } while (0)
#define PG8_WAIT_V(n) asm volatile("s_waitcnt vmcnt(" #n ")" ::: "memory")
#define PG8_WAIT_L(n) asm volatile("s_waitcnt lgkmcnt(" #n ")" ::: "memory")
#define PG8_BAR __builtin_amdgcn_s_barrier()
#define PG8_SCHED __builtin_amdgcn_sched_barrier(0)
    Unit cur, nxt; int ui = 0;
    if (!S.next(0, cur)) return;
    f32x4 acc[2][2][4][2];
    if constexpr (Epi::INIT) E.init(acc, cur, wr, wc, fr, fq);
    else {
#pragma unroll
    for (int a = 0; a < 2; ++a)
#pragma unroll
        for (int b = 0; b < 2; ++b)
#pragma unroll
            for (int m = 0; m < 4; ++m)
#pragma unroll
                for (int n = 0; n < 2; ++n) acc[a][b][m][n] = (f32x4){0.f, 0.f, 0.f, 0.f};
    }
    bf16x8 At[4][2], B0[2][2], B1[2][2];
    const char* cA = (const char*)g.A + (size_t)cur.pm * tstepA + (size_t)cur.pn * g.a_pn_off * 2; const char* cB = (const char*)g.Bt + (size_t)cur.pn * tstepB + (HALFN ? (size_t)(cur.half - 1) * hstepB : (size_t)0);
    PG8_STAGE(PG8_SB(0, 0), cB, voffB); PG8_STAGE(PG8_SB(0, 1), cB + hstepB, voffB); PG8_STAGE(PG8_SA(0, 0), cA, voffA); PG8_STAGE(PG8_SA(0, 1), cA + hstepA, voffA);
    if (wr == 1) PG8_BAR;
    PG8_WAIT_V(2); PG8_BAR;
    PG8_STAGE(PG8_SB(1, 0), cB + kstep, voffB); PG8_STAGE(PG8_SA(1, 0), cA + kstep, voffA); PG8_STAGE(PG8_SB(1, 1), cB + hstepB + kstep, voffB);
    PG8_WAIT_V(6); PG8_BAR;
    for (;;) {
        const bool has_next = S.next(ui + 1, nxt);
        const char* nA = has_next ? (const char*)g.A + (size_t)nxt.pm * tstepA + (size_t)nxt.pn * g.a_pn_off * 2 : cA; const char* nB = has_next ? (const char*)g.Bt + (size_t)nxt.pn * tstepB + (HALFN ? (size_t)(nxt.half - 1) * hstepB : (size_t)0) : cB;
#pragma unroll 1
        for (int t = 0; t < nt; t += 2) {
            const bool last = (t == nt - 2);
            if constexpr (Epi::SEAMS) { if (t == Epi::SEAM0 || t == Epi::SEAM1) E.seam(acc, cur, t == Epi::SEAM0 ? 0 : 1, wr, wc, fr, fq); }
            const char* a1 = cA + (size_t)(t + 1) * kstep;
            const char* a2 = last ? nA : cA + (size_t)(t + 2) * kstep; const char* b2 = last ? nB : cB + (size_t)(t + 2) * kstep;
            const char* a3 = a2 + kstep; const char* b3 = b2 + kstep;
            PG8_LDB(B0, 0, 0); if constexpr (!HALFN) PG8_LDB(B1, 0, 1); PG8_SCHED; PG8_LDA(At, 0, 0); PG8_STAGE(PG8_SA(1, 1), a1 + hstepA, voffA);
            PG8_WAIT_V(8); PG8_WAIT_L(0); PG8_BAR; PG8_MMA(0, 0, At, B0); if constexpr (!HALFN) PG8_MMA(0, 1, At, B1); PG8_BAR; PG8_SCHED;
            PG8_LDA(At, 0, 1); PG8_STAGE(PG8_SB(0, 0), b2, voffB); PG8_STAGE(PG8_SB(0, 1), b2 + hstepB, voffB); PG8_STAGE(PG8_SA(0, 0), a2, voffA);
            PG8_WAIT_V(8); PG8_WAIT_L(0); PG8_BAR; PG8_MMA(1, 0, At, B0); if constexpr (!HALFN) PG8_MMA(1, 1, At, B1); PG8_BAR; PG8_SCHED;
            PG8_LDB(B0, 1, 0); if constexpr (!HALFN) PG8_LDB(B1, 1, 1); PG8_SCHED; PG8_LDA(At, 1, 0); PG8_STAGE(PG8_SA(0, 1), a2 + hstepA, voffA);
            PG8_WAIT_V(8); PG8_WAIT_L(0); PG8_BAR; PG8_MMA(0, 0, At, B0); if constexpr (!HALFN) PG8_MMA(0, 1, At, B1); PG8_BAR; PG8_SCHED;
            PG8_LDA(At, 1, 1); PG8_STAGE(PG8_SB(1, 0), b3, voffB); PG8_STAGE(PG8_SB(1, 1), b3 + hstepB, voffB); PG8_STAGE(PG8_SA(1, 0), a3, voffA);
            PG8_WAIT_V(8); PG8_WAIT_L(0); PG8_BAR; PG8_MMA(1, 0, At, B0); if constexpr (!HALFN) PG8_MMA(1, 1, At, B1); PG8_BAR; PG8_SCHED;
        }
        if (wr == 0) PG8_BAR;
        E(acc, cur, wr, wc, fr, fq);
        if (!has_next) break;
        if constexpr (Epi::INIT) E.init(acc, nxt, wr, wc, fr, fq);
        else {
#pragma unroll
        for (int a = 0; a < 2; ++a)
#pragma unroll
            for (int b = 0; b < 2; ++b)
#pragma unroll
                for (int m = 0; m < 4; ++m)
#pragma unroll
                    for (int n = 0; n < 2; ++n) acc[a][b][m][n] = (f32x4){0.f, 0.f, 0.f, 0.f};
        }
        cur = nxt; cA = nA; cB = nB; ++ui;
        if (wr == 1) PG8_BAR;
    }
    PG8_WAIT_V(0);
    PG8_BAR;
#undef PG8_SA
#undef PG8_SB
#undef PG8_STAGE
#undef PG8_LDA
#undef PG8_LDB
#undef PG8_MMA
#undef PG8_WAIT_V
#undef PG8_WAIT_L
#undef PG8_BAR
#undef PG8_SCHED
}
}
using pg8::Unit;

#define EPI_OPAQUE asm volatile("" : "+v"(fr), "+v"(fq));
#define EPI_ROWS_BEGIN _Pragma("unroll") for (int ai = 0; ai < 2; ++ai) _Pragma("unroll") for (int m = 0; m < 4; ++m) { const int row = u.pm * 256 + ai * 128 + wr * 64 + m * 16 + fr;
#define EPI_COLS_BEGIN _Pragma("unroll") for (int bj = 0; bj < 2; ++bj) { const int col = u.pn * 256 + bj * 128 + wc * 32 + 8 * fq;
#define EPI_END }

struct EpiProj {
    static constexpr bool SEAMS = false, INIT = false; static constexpr int SEAM0 = -1, SEAM1 = -1;
    bf16_t* P; const float* ssq; int pn0;
    __device__ __forceinline__ void seam(f32x4 (&)[2][2][4][2], const Unit&, int, int, int, int, int) const {}
    template <int ACT> __device__ __forceinline__ void body(f32x4 (&acc)[2][2][4][2], const Unit& u, int wr, int wc, int fr, int fq, int obase, const float (&rsv)[2][4]) const {
        EPI_ROWS_BEGIN
            const float rs = rsv[ai][m];
#pragma unroll
            for (int bj = 0; bj < 2; ++bj) { const int col = obase + bj * 128 + wc * 32 + 8 * fq;
                f32x4 v0 = acc[ai][bj][m][0] * rs, v1 = acc[ai][bj][m][1] * rs;
                if (ACT == 1) {
#pragma unroll
                    for (int j = 0; j < 4; ++j) { v0[j] = silu_f(v0[j]); v1[j] = silu_f(v1[j]); } }
                if (ACT == 2) {
#pragma unroll
                    for (int j = 0; j < 4; ++j) { v0[j] = sigmoid_f(v0[j]); v1[j] = sigmoid_f(v1[j]); } }
                __builtin_nontemporal_store(pack8(v0, v1), (u32x4*)(P + (size_t)row * NCO + col));
            }
        EPI_END
    }
    __device__ __forceinline__ void body_gate(f32x4 (&acc)[2][2][4][2], const Unit& u, int wr, int wc, int fr, int fq, int gbase, const float (&rsv)[2][4]) const {
        EPI_ROWS_BEGIN
            const float rs = rsv[ai][m];
#pragma unroll
            for (int bj = 0; bj < 2; ++bj) { if (u.half != 0 && bj == 1) continue;
                const int gcol = gbase + (bj + (u.half == 2 ? 1 : 0)) * 128 + wc * 32 + 8 * fq;
                f32x4 v0 = acc[ai][bj][m][0] * rs, v1 = acc[ai][bj][m][1] * rs;
#pragma unroll
                for (int j = 0; j < 4; ++j) { v0[j] = sigmoid_f(v0[j]); v1[j] = sigmoid_f(v1[j]); }
                u32x2 w; w.x = pk_unorm8(v0); w.y = pk_unorm8(v1);
                *(u32x2*)((unsigned char*)P + (size_t)row * ROWB + GATE_B0 + gcol) = w;
            }
        EPI_END
    }
    template <int ACT> __device__ __forceinline__ void body_pair(f32x4 (&acc)[2][2][4][2], const Unit& u, int wr, int wc, int fr, int fq, int obase, const float (&rsv)[2][4]) const {
        EPI_ROWS_BEGIN
            const float rs = rsv[ai][m]; const int col = obase + wc * 32 + 8 * fq;
            f32x4 a0 = acc[ai][0][m][0] * rs, a1 = acc[ai][0][m][1] * rs, b0 = acc[ai][1][m][0] * rs, b1 = acc[ai][1][m][1] * rs;
            if (ACT == 1) {
#pragma unroll
                for (int j = 0; j < 4; ++j) { b0[j] = silu_f(b0[j]); b1[j] = silu_f(b1[j]); } }
            if (ACT == 2) {
#pragma unroll
                for (int j = 0; j < 4; ++j) { b0[j] = sigmoid_f(b0[j]); b1[j] = sigmoid_f(b1[j]); } }
            __builtin_nontemporal_store(pack8(a0 * b0, a1 * b1), (u32x4*)(P + (size_t)row * NCO + col));
        EPI_END
    }
    __device__ __forceinline__ void operator()(f32x4 (&acc)[2][2][4][2], const Unit& u, int wr, int wc, int fr, int fq) const {
        EPI_OPAQUE
        float rsv[2][4];
#pragma unroll
        for (int ai = 0; ai < 2; ++ai)
#pragma unroll
            for (int m = 0; m < 4; ++m) rsv[ai][m] = ssq[u.pm * 256 + ai * 128 + wr * 64 + m * 16 + fr];
        asm volatile("" ::: "memory");
#pragma unroll
        for (int ai = 0; ai < 2; ++ai)
#pragma unroll
            for (int m = 0; m < 4; ++m) rsv[ai][m] = __builtin_amdgcn_rsqf(rsv[ai][m] * (1.0f / DM) + RMS_EPS);
        const int pn = u.pn + pn0;
        if (pn < 8) body_pair<0>(acc, u, wr, wc, fr, fq, OQ + pn * 128, rsv);
        else if (pn < 16) body_pair<1>(acc, u, wr, wc, fr, fq, OAB + (pn - 8) * 128, rsv);
        else if (pn < 20) body<0>(acc, u, wr, wc, fr, fq, OBIN + (pn - 16) * 256, rsv);
        else if (pn < 24) body<1>(acc, u, wr, wc, fr, fq, OBZ + (pn - 20) * 256, rsv);
        else if (pn < 32) body_pair<2>(acc, u, wr, wc, fr, fq, OV + (pn - 24) * 128, rsv);
        else if (pn < 36) body<1>(acc, u, wr, wc, fr, fq, OCZ + (pn - 32) * 256, rsv);
        else body_gate(acc, u, wr, wc, fr, fq, (pn - 36) * 256, rsv);
    }
};
struct EpiPlain {
    static constexpr bool SEAMS = false, INIT = false; static constexpr int SEAM0 = -1, SEAM1 = -1;
    bf16_t* O; int ldo;
    __device__ __forceinline__ void seam(f32x4 (&)[2][2][4][2], const Unit&, int, int, int, int, int) const {}
    __device__ __forceinline__ void operator()(f32x4 (&acc)[2][2][4][2], const Unit& u, int wr, int wc, int fr, int fq) const {
        EPI_OPAQUE
        EPI_ROWS_BEGIN EPI_COLS_BEGIN
            *(u32x4*)(O + (size_t)row * ldo + col) = pack8(acc[ai][bj][m][0], acc[ai][bj][m][1]);
        EPI_END EPI_END
    }
};
struct EpiPool {
    static constexpr bool SEAMS = false, INIT = false; static constexpr int SEAM0 = -1, SEAM1 = -1;
    bf16_t* Y; const float* pscale; const bf16_t* P;
    __device__ __forceinline__ void seam(f32x4 (&)[2][2][4][2], const Unit&, int, int, int, int, int) const {}
    __device__ __forceinline__ void operator()(f32x4 (&acc)[2][2][4][2], const Unit& u, int wr, int wc, int fr, int fq) const {
        EPI_OPAQUE
#pragma unroll
        for (int ai = 0; ai < 2; ++ai) {
            u32x4 zz[4][2];
#pragma unroll
            for (int m = 0; m < 4; ++m)
#pragma unroll
                for (int bj = 0; bj < 2; ++bj) { const int row = u.pm * 256 + ai * 128 + wr * 64 + m * 16 + fr, col = u.pn * 256 + bj * 128 + wc * 32 + 8 * fq;
                    zz[m][bj] = *(const u32x4*)(P + (size_t)row * NCO + OBZ + col); }
            asm volatile("" ::: "memory");
#pragma unroll
            for (int m = 0; m < 4; ++m)
#pragma unroll
                for (int bj = 0; bj < 2; ++bj) { const int row = u.pm * 256 + ai * 128 + wr * 64 + m * 16 + fr, col = u.pn * 256 + bj * 128 + wc * 32 + 8 * fq;
                    const f32x4 s0 = *(const f32x4*)(pscale + col), s1 = *(const f32x4*)(pscale + col + 4);
                    f32x4 z0, z1; unpack8(zz[m][bj], z0, z1);
                    *(u32x4*)(Y + (size_t)row * YW + EW + col) = pack8(acc[ai][bj][m][0] * s0 * z0, acc[ai][bj][m][1] * s1 * z1); }
            asm volatile("" ::: "memory");
        }
    }
};
struct EpiMerge {
    static constexpr bool SEAMS = true, INIT = false; static constexpr int SEAM0 = EW / 64, SEAM1 = 2 * EW / 64;
    const bf16_t* P; bf16_t* MG;
    __device__ __forceinline__ void seam(f32x4 (&acc)[2][2][4][2], const Unit& u, int n, int wr, int wc, int fr, int fq) const {
        EPI_OPAQUE
#pragma unroll
        for (int ai = 0; ai < 2; ++ai) {
            u32x2 ga[4][2], gb[4][2];
#pragma unroll
            for (int m = 0; m < 4; ++m)
#pragma unroll
                for (int bj = 0; bj < 2; ++bj) { const int row = u.pm * 256 + ai * 128 + wr * 64 + m * 16 + fr, col = u.pn * 256 + bj * 128 + wc * 32 + 8 * fq;
                    const unsigned char* gp = (const unsigned char*)P + (size_t)row * ROWB + GATE_B0 + n * DM + col; ga[m][bj] = *(const u32x2*)gp; gb[m][bj] = *(const u32x2*)(gp + DM); }
#pragma unroll
            for (int m = 0; m < 4; ++m)
#pragma unroll
                for (int bj = 0; bj < 2; ++bj) { const f32x4 a0 = un_unorm8(ga[m][bj].x), a1 = un_unorm8(ga[m][bj].y), b0 = un_unorm8(gb[m][bj].x), b1 = un_unorm8(gb[m][bj].y);
#pragma unroll
                    for (int j = 0; j < 4; ++j) { acc[ai][bj][m][0][j] *= a0[j] * __builtin_amdgcn_rcpf(b0[j]); acc[ai][bj][m][1][j] *= a1[j] * __builtin_amdgcn_rcpf(b1[j]); } }
            asm volatile("" ::: "memory");
        }
    }
    __device__ __forceinline__ void operator()(f32x4 (&acc)[2][2][4][2], const Unit& u, int wr, int wc, int fr, int fq) const {
        EPI_OPAQUE
#pragma unroll
        for (int ai = 0; ai < 2; ++ai) {
            u32x2 gg[4][2];
#pragma unroll
            for (int m = 0; m < 4; ++m)
#pragma unroll
                for (int bj = 0; bj < 2; ++bj) { const int row = u.pm * 256 + ai * 128 + wr * 64 + m * 16 + fr, col = u.pn * 256 + bj * 128 + wc * 32 + 8 * fq;
                    gg[m][bj] = *(const u32x2*)((const unsigned char*)P + (size_t)row * ROWB + GATE_B0 + 2 * DM + col); }
            asm volatile("" ::: "memory");
#pragma unroll
            for (int m = 0; m < 4; ++m)
#pragma unroll
                for (int bj = 0; bj < 2; ++bj) { const int row = u.pm * 256 + ai * 128 + wr * 64 + m * 16 + fr, col = u.pn * 256 + bj * 128 + wc * 32 + 8 * fq;
                    const f32x4 g0 = un_unorm8(gg[m][bj].x) * (1.0f / 255.0f), g1 = un_unorm8(gg[m][bj].y) * (1.0f / 255.0f);
                    *(u32x4*)(MG + (size_t)row * DM + col) = pack8(acc[ai][bj][m][0] * g0, acc[ai][bj][m][1] * g1); }
            asm volatile("" ::: "memory");
        }
    }
};
struct EpiWo {
    static constexpr bool SEAMS = false, INIT = true; static constexpr int SEAM0 = -1, SEAM1 = -1;
    const float* basef; const bf16_t* baseb; bf16_t* HB;
    __device__ __forceinline__ void seam(f32x4 (&)[2][2][4][2], const Unit&, int, int, int, int, int) const {}
    __device__ __forceinline__ void init(f32x4 (&acc)[2][2][4][2], const Unit& u, int wr, int wc, int fr, int fq) const {
        EPI_OPAQUE
        if (basef) {
            EPI_ROWS_BEGIN EPI_COLS_BEGIN
                const size_t off = (size_t)row * DM + col;
                acc[ai][bj][m][0] = *(const f32x4*)(basef + off); acc[ai][bj][m][1] = *(const f32x4*)(basef + off + 4);
            EPI_END EPI_END
        } else {
            EPI_ROWS_BEGIN EPI_COLS_BEGIN
                unpack8(*(const u32x4*)(baseb + (size_t)row * DM + col), acc[ai][bj][m][0], acc[ai][bj][m][1]);
            EPI_END EPI_END
        }
    }
    __device__ __forceinline__ void operator()(f32x4 (&acc)[2][2][4][2], const Unit& u, int wr, int wc, int fr, int fq) const {
        EPI_OPAQUE
        EPI_ROWS_BEGIN EPI_COLS_BEGIN
            *(u32x4*)(HB + (size_t)row * DM + col) = pack8(acc[ai][bj][m][0], acc[ai][bj][m][1]);
        EPI_END EPI_END
    }
};
struct EpiGate {
    static constexpr bool SEAMS = false, INIT = false; static constexpr int SEAM0 = -1, SEAM1 = -1;
    const bf16_t* H1; const bf16_t* PLE; bf16_t* HB; float* ssq;
    __device__ __forceinline__ void seam(f32x4 (&)[2][2][4][2], const Unit&, int, int, int, int, int) const {}
    __device__ __forceinline__ void operator()(f32x4 (&acc)[2][2][4][2], const Unit& u, int wr, int wc, int fr, int fq) const {
        EPI_OPAQUE
        const int row0 = u.pm * 256 + wr * 64 + fr, col0 = u.pn * 256 + wc * 32 + 8 * fq;
        u32x4 hA[2][2], pA[2][2];
#define GATE_LOAD(r, b) do { const int row_ = row0 + ((r) >> 2) * 128 + ((r) & 3) * 16; _Pragma("unroll") for (int bj = 0; bj < 2; ++bj) { const size_t off_ = (size_t)row_ * DM + col0 + bj * 128; \
            hA[b][bj] = *(const u32x4*)(H1 + off_); pA[b][bj] = *(const u32x4*)(PLE + off_); } } while (0)
        GATE_LOAD(0, 0);
#pragma unroll
        for (int r = 0; r < 8; ++r) {
            const int ai = r >> 2, m = r & 3, b = r & 1;
            if (r + 1 < 8) GATE_LOAD(r + 1, (r + 1) & 1);
            const int row = row0 + ai * 128 + m * 16;
            float ss = 0.f;
#pragma unroll
            for (int bj = 0; bj < 2; ++bj) {
                const size_t off = (size_t)row * DM + col0 + bj * 128;
                f32x4 p0, p1, o0, o1; unpack8(pA[b][bj], p0, p1); unpack8(hA[b][bj], o0, o1);
#pragma unroll
                for (int j = 0; j < 4; ++j) { o0[j] += sigmoid_f(acc[ai][bj][m][0][j]) * p0[j]; o1[j] += sigmoid_f(acc[ai][bj][m][1][j]) * p1[j]; }
                *(u32x4*)(HB + off) = pack8(o0, o1);
#pragma unroll
                for (int j = 0; j < 4; ++j) ss += o0[j] * o0[j] + o1[j] * o1[j];
            }
            ss += __shfl_xor(ss, 16); ss += __shfl_xor(ss, 32);
            if (fq == 0) atomicAdd(ssq + row, ss);
            asm volatile("" ::: "memory");
        }
#undef GATE_LOAD
    }
};

struct Args { const float* in[16]; float* out; unsigned char* ws; int ph_lo, ph_hi; };
enum { I_X = 0, I_P, I_NG, I_WIN, I_CAW, I_PW, I_PS, I_CCW, I_CCB, I_LNG, I_LNB, I_WBO, I_WO, I_WPG, I_WPP, I_FNG };

__device__ __forceinline__ void transpose_item(const float* __restrict__ W, int N, bf16_t* __restrict__ WT, int ldT, int k0, int n0, const float* __restrict__ kscale, LAS float* scr, int lane, int d0 = -1) {
    if (d0 < 0) d0 = n0;
    const int r = lane >> 4, c4 = lane & 15;
    f32x4 v[16]; float ks[16];
#pragma unroll
    for (int i = 0; i < 16; ++i) { const int kk = 4 * i + r; v[i] = __builtin_nontemporal_load((const f32x4*)(W + (size_t)(k0 + kk) * N + n0 + 4 * c4)); ks[i] = kscale ? kscale[k0 + kk] : 1.0f; }
    asm volatile("" ::: "memory");
#pragma unroll
    for (int i = 0; i < 16; ++i) { const int kk = 4 * i + r; const f32x4 w = v[i] * ks[i];
        LAS float* sp = scr + kk * 65 + 4 * c4; sp[0] = w[0]; sp[1] = w[1]; sp[2] = w[2]; sp[3] = w[3]; }
    asm volatile("s_waitcnt lgkmcnt(0)" ::: "memory");
    const int c = lane & 7;
#pragma unroll
    for (int j = 0; j < 8; ++j) { const int nn = (lane >> 3) + 8 * j; const LAS float* s = scr + (8 * c) * 65 + nn;
        u32x4 o; o.x = cvt_pk_bf16(s[0 * 65], s[1 * 65]); o.y = cvt_pk_bf16(s[2 * 65], s[3 * 65]); o.z = cvt_pk_bf16(s[4 * 65], s[5 * 65]); o.w = cvt_pk_bf16(s[6 * 65], s[7 * 65]);
        *(u32x4*)(WT + (size_t)(d0 + nn) * ldT + k0 + 8 * c) = o; }
    asm volatile("s_waitcnt lgkmcnt(0)" ::: "memory");
}
__device__ __forceinline__ float wave_sum(float v) {
#pragma unroll
    for (int o = 1; o < 64; o <<= 1) v += __shfl_xor(v, o);
    return v;
}
__device__ __forceinline__ void p0_prologue(const Args& a, LAS unsigned char* lds) {
    int tid = threadIdx.x; asm volatile("" : "+v"(tid));
    const int lane = tid & 63, wave = __builtin_amdgcn_readfirstlane(tid >> 6);
    LAS float* scr = (LAS float*)(lds + wave * 16640);
    const int gw = blockIdx.x * 8 + wave, NGW = gridDim.x * 8;
    unsigned char* ws = a.ws;
    constexpr int I_IN = 32 * 240, I_BO = 3 * 16 * 32, I_O = 32 * 32, I_G = 32 * 32, I_PP = 4 * 32, I_PL = 4 * 16;
    constexpr int PER_LAYER = I_IN + I_BO + I_O + I_G + I_PP + I_PL;
    for (int it = gw; it < DEPTH * PER_LAYER; it += NGW) {
        const int l = it / PER_LAYER; int r = it % PER_LAYER;
        if (r < I_IN) { const int kb = r / 240, nb = r % 240;
            const int c0 = 64 * nb, sl = c0 >> 10, e = c0 & 1023, pr = (e >> 7) * 256 + (e & 127); int d0 = c0;
            if (sl == 0) d0 = pr; else if (sl == 2) d0 = pr + 128; else if (sl == 1) d0 = 2048 + pr; else if (sl == 3) d0 = 2048 + pr + 128;
            else if (sl == 4) d0 = 4096 + e; else if (sl == 5) d0 = 5120 + e; else if (sl == 6) d0 = 6144 + pr; else if (sl == 7) d0 = 6144 + pr + 128; else if (sl == 8) d0 = 8192 + e;
            transpose_item(a.in[I_WIN] + (size_t)l * DM * NC, NC, (bf16_t*)(ws + WS_WI + l * SZ_WI), DM, 64 * kb, c0, a.in[I_NG] + l * DM, scr, lane, d0); continue; }
        r -= I_IN;
        if (r < I_BO) { const int n = r / 512, q = r % 512, kb = q / 32, nb = q % 32;
            transpose_item(a.in[I_WBO] + ((size_t)l * 3 + n) * EW * DM, DM, (bf16_t*)(ws + WS_WB + l * SZ_WB) + n * EW, YW, 64 * kb, 64 * nb, nullptr, scr, lane); continue; }
        r -= I_BO;
        if (r < I_O) { const int kb = r / 32, nb = r % 32;
            transpose_item(a.in[I_WO] + (size_t)l * DM * DM, DM, (bf16_t*)(ws + WS_WO + l * SZ_WO), DM, 64 * kb, 64 * nb, nullptr, scr, lane); continue; }
        r -= I_O;
        if (r < I_G) { const int kb = r / 32, nb = r % 32;
            transpose_item(a.in[I_WPG] + (size_t)l * DM * DM, DM, (bf16_t*)(ws + WS_WG + l * SZ_WO), DM, 64 * kb, 64 * nb, nullptr, scr, lane); continue; }
        r -= I_G;
        if (r < I_PP) { const int kb = r / 32, nb = r % 32;
            transpose_item(a.in[I_WPP] + (size_t)l * PD * DM, DM, (bf16_t*)(ws + WS_WP + l * SZ_WP), PD, 64 * kb, 64 * nb, nullptr, scr, lane); continue; }
        r -= I_PP;
        { const int gq = r / 16, q = r % 16, kb = q / 4, nb = q % 4;
            transpose_item(a.in[I_PW] + ((size_t)l * 4 + gq) * 256 * 256, 256, (bf16_t*)(ws + WS_PW + l * SZ_PW) + (size_t)gq * 256 * 256, 256, 64 * kb, 64 * nb, nullptr, scr, lane); }
    }
    float* ssq = (float*)(ws + WS_SSQ);
    bf16_t* hb0 = (bf16_t*)(ws + WS_HB0);
    for (int mrow = gw; mrow < MTOK; mrow += NGW) {
        const f32x4* xr = (const f32x4*)(a.in[I_X] + (size_t)mrow * DM) + lane;
        u32x2* o8 = (u32x2*)(hb0 + (size_t)mrow * DM) + lane;
        float s = 0.f; f32x4 xv[8];
#pragma unroll
        for (int j = 0; j < 8; ++j) xv[j] = __builtin_nontemporal_load(xr + 64 * j);
        asm volatile("" ::: "memory");
#pragma unroll
        for (int j = 0; j < 8; ++j) { const f32x4 v = xv[j]; s += (v[0] * v[0] + v[1] * v[1]) + (v[2] * v[2] + v[3] * v[3]);
            u32x2 w; w.x = cvt_pk_bf16(v[0], v[1]); w.y = cvt_pk_bf16(v[2], v[3]); o8[64 * j] = w; }
        s = wave_sum(s);
        if (lane == 0) { ssq[mrow] = s; ssq[MTOK + mrow] = 0.f; ssq[2 * MTOK + mrow] = 0.f; }
    }
    {
        const f32x4* ps = (const f32x4*)a.in[I_P]; u32x2* pd = (u32x2*)(ws + WS_PB);
        const size_t n4 = (size_t)DEPTH * MTOK * PD / 4, stride = (size_t)gridDim.x * 512;
        size_t i = (size_t)blockIdx.x * 512 + tid;
        for (; i + 3 * stride < n4; i += 4 * stride) { f32x4 v[4];
#pragma unroll
            for (int q = 0; q < 4; ++q) v[q] = __builtin_nontemporal_load(ps + i + q * stride);
            asm volatile("" ::: "memory");
#pragma unroll
            for (int q = 0; q < 4; ++q) { u32x2 w; w.x = cvt_pk_bf16(v[q][0], v[q][1]); w.y = cvt_pk_bf16(v[q][2], v[q][3]); pd[i + q * stride] = w; } }
        for (; i < n4; i += stride) { const f32x4 v = ps[i]; u32x2 w; w.x = cvt_pk_bf16(v[0], v[1]); w.y = cvt_pk_bf16(v[2], v[3]); pd[i] = w; }
    }
}

constexpr int TT = 16;
template <int H, int Q> __device__ __forceinline__ void red_one(float (&x)[2 * TT], bool up) { const float a = x[Q + H], b = x[Q]; const float keep = up ? a : b, send = up ? b : a; x[Q] = keep + __shfl_xor(send, H); }
template <int H, int... Q> __device__ __forceinline__ void red_step(float (&x)[2 * TT], int lane, std::integer_sequence<int, Q...>) { const bool up = (lane & H) != 0; (red_one<H, Q>(x, up), ...); }
__device__ __forceinline__ float wave_reduce32(float (&x)[2 * TT], int lane) {
    static_assert(TT == 16, "reduce written for 32 values");
    red_step<16>(x, lane, std::make_integer_sequence<int, 16>{});
    red_step<8>(x, lane, std::make_integer_sequence<int, 8>{});
    red_step<4>(x, lane, std::make_integer_sequence<int, 4>{});
    red_step<2>(x, lane, std::make_integer_sequence<int, 2>{});
    red_step<1>(x, lane, std::make_integer_sequence<int, 1>{});
    return x[0] + __shfl_xor(x[0], 32);
}
template <int W>
__device__ __forceinline__ void pool_branch(const bf16_t* __restrict__ Pb, bf16_t* __restrict__ out, bool first) {
    unsigned raw[W - 1 + TT];
#pragma unroll
    for (int j = 0; j < W - 1 + TT; ++j) { const int off = j - (W - 1); const int offc = (off < 0 && first) ? 0 : off;
        unsigned r = *(const unsigned*)(Pb + (ptrdiff_t)offc * NCO); if (off < 0 && first) r = 0u; raw[j] = r; }
    asm volatile("" ::: "memory");
    f32x2 S = (f32x2){0.f, 0.f};
#pragma unroll
    for (int j = 0; j < W - 1; ++j) S += un2(raw[j]);
#pragma unroll
    for (int i = 0; i < TT; ++i) {
        const f32x2 ui = un2(raw[i + W - 1]);
        S += ui;
        const float inv = (first && (i + 1 < W)) ? 1.0f / (float)(i + 1) : 1.0f / (float)W;
        st2(out + (size_t)i * EW, S * inv - ui);
        S -= un2(raw[i]);
    }
}
constexpr int CSTEPS = TT + 30;
template <int NDEAD, int B>
__device__ __forceinline__ void conv31_load(const bf16_t* __restrict__ Pt, unsigned (&cv)[8]) {
#pragma unroll
    for (int q = 0; q < 8; ++q) { const int JJ = 8 * B + q; if (JJ >= NDEAD && JJ < CSTEPS) cv[q] = *(const unsigned*)(Pt + (ptrdiff_t)(JJ - 30) * NCO + OV); }
}
template <int NDEAD, int B>
__device__ __forceinline__ void conv31_comp(const unsigned (&cv)[8], const f32x2 (&wk)[31], f32x2 (&acc)[TT]) {
#pragma unroll
    for (int q = 0; q < 8; ++q) { const int JJ = 8 * B + q; if (JJ >= NDEAD && JJ < CSTEPS) { const f32x2 v = un2(cv[q]);
#pragma unroll
        for (int i = 0; i < TT; ++i) { const int k = JJ - i; if (k >= 0 && k <= 30) acc[i] += wk[k] * v; } } }
}
#define MIX_ISSUED() asm volatile("" ::: "memory")
template <int NDEAD>
__device__ __forceinline__ void conv31_all(const bf16_t* __restrict__ Pt, const f32x2 (&wk)[31], f32x2 (&acc)[TT]) {
    static_assert(CSTEPS <= 48, "six batches of eight steps");
    unsigned cA[8], cB[8];
    conv31_load<NDEAD, 0>(Pt, cA); conv31_load<NDEAD, 1>(Pt, cB); MIX_ISSUED();
    conv31_comp<NDEAD, 0>(cA, wk, acc); conv31_load<NDEAD, 2>(Pt, cA); MIX_ISSUED();
    conv31_comp<NDEAD, 1>(cB, wk, acc); conv31_load<NDEAD, 3>(Pt, cB); MIX_ISSUED();
    conv31_comp<NDEAD, 2>(cA, wk, acc); conv31_load<NDEAD, 4>(Pt, cA); MIX_ISSUED();
    conv31_comp<NDEAD, 3>(cB, wk, acc); conv31_load<NDEAD, 5>(Pt, cB); MIX_ISSUED();
    conv31_comp<NDEAD, 4>(cA, wk, acc);
    conv31_comp<NDEAD, 5>(cB, wk, acc);
}

__device__ __forceinline__ void mixer_phase(const Args& a, int l, LAS unsigned char* lds, int tile0, int tstride, int tend) {
    int tid = threadIdx.x; asm volatile("" : "+v"(tid));
    const int lane = tid & 63, wave = __builtin_amdgcn_readfirstlane(tid >> 6);
    const int e0 = 2 * tid;
    const bf16_t* P = (const bf16_t*)(a.ws + WS_PROJ);
    bf16_t* Y = (bf16_t*)(a.ws + WS_Y);
    bf16_t* PO = (bf16_t*)(a.ws + WS_POOL);
    LAS float* red = (LAS float*)lds;
    LAS float* fin = (LAS float*)(lds + 1024);
    for (int ti = tile0; ti < tend; ti += tstride) {
        const int t0 = ti * TT, s0 = t0 % SEQ; const bool first = (s0 == 0);
        const bf16_t* Pt = P + (size_t)t0 * NCO + e0;
        {
            const float* cw = a.in[I_CAW] + (size_t)l * 3 * EW + e0;
            const f32x2 w0 = *(const f32x2*)cw, w1 = *(const f32x2*)(cw + EW), w2 = *(const f32x2*)(cw + 2 * EW);
            f32x2 q2 = (f32x2){0.f, 0.f}, q1 = (f32x2){0.f, 0.f};
            if (!first) { q2 = ld2(Pt - 2 * (ptrdiff_t)NCO + OQ); q1 = ld2(Pt - (ptrdiff_t)NCO + OQ); }
            unsigned rA[TT][2];
#pragma unroll
            for (int i = 0; i < TT; ++i) { const bf16_t* pr = Pt + (size_t)i * NCO; rA[i][0] = *(const unsigned*)(pr + OQ); rA[i][1] = *(const unsigned*)(pr + OAB); }
            MIX_ISSUED();
#pragma unroll
            for (int i = 0; i < TT; ++i) {
                const f32x2 q = un2(rA[i][0]), abz = un2(rA[i][1]);
                const f32x2 cv = w0 * q2 + w1 * q1 + w2 * q;
                st2(Y + (size_t)(t0 + i) * YW + e0, abz * cv);
                q2 = q1; q1 = q;
            }
        }
        asm volatile("" ::: "memory");
        {
            const bf16_t* Pb = Pt + OBIN; bf16_t* po = PO + (size_t)t0 * EW + e0;
            const int grp = wave >> 1;
            if (grp == 0) pool_branch<2>(Pb, po, first);
            else if (grp == 1) pool_branch<4>(Pb, po, first);
            else if (grp == 2) pool_branch<8>(Pb, po, first);
            else pool_branch<16>(Pb, po, first);
        }
        asm volatile("" ::: "memory");
        {
            const float* cw = a.in[I_CCW] + (size_t)l * 31 * EW + e0;
            f32x2 wk[31];
#pragma unroll
            for (int k = 0; k < 31; ++k) wk[k] = *(const f32x2*)(cw + (size_t)k * EW);
            const f32x2 bias = *(const f32x2*)(a.in[I_CCB] + (size_t)l * EW + e0);
            f32x2 acc[TT];
#pragma unroll
            for (int i = 0; i < TT; ++i) acc[i] = bias;
            if (s0 == 0) conv31_all<30>(Pt, wk, acc);
            else if (s0 == TT) conv31_all<30 - TT>(Pt, wk, acc);
            else conv31_all<0>(Pt, wk, acc);
            float st[2 * TT];
#pragma unroll
            for (int i = 0; i < TT; ++i) { st[2 * i] = acc[i].x + acc[i].y; st[2 * i + 1] = acc[i].x * acc[i].x + acc[i].y * acc[i].y; }
            const float tot = wave_reduce32(st, lane);
            __syncthreads();
            if (lane < 32) red[wave * 32 + lane] = tot;
            __syncthreads();
            if (tid < 32) { float s = 0.f;
#pragma unroll
                for (int w = 0; w < 8; ++w) s += red[w * 32 + tid];
                fin[tid] = s; }
            __syncthreads();
            const f32x2 lg = *(const f32x2*)(a.in[I_LNG] + (size_t)l * EW + e0), lb = *(const f32x2*)(a.in[I_LNB] + (size_t)l * EW + e0);
            unsigned rz[TT];
#pragma unroll
            for (int i = 0; i < TT; ++i) rz[i] = *(const unsigned*)(Pt + (size_t)i * NCO + OCZ);
            MIX_ISSUED();
#pragma unroll
            for (int i = 0; i < TT; ++i) {
                const float mean = fin[2 * i] * (1.0f / EW);
                const float var = fmaxf(fin[2 * i + 1] * (1.0f / EW) - mean * mean, 0.f);
                const float rstd = __builtin_amdgcn_rsqf(var + LN_EPS);
                f32x2 y = (acc[i] - mean) * rstd * lg + lb;
                y.x = silu_f(y.x); y.y = silu_f(y.y);
                st2(Y + (size_t)(t0 + i) * YW + 2 * EW + e0, y * un2(rz[i]));
            }
        }
    }
}

__device__ __forceinline__ void final_phase(const Args& a) {
    int tid = threadIdx.x; asm volatile("" : "+v"(tid));
    const int lane = tid & 63, wave = tid >> 6;
    const int gw = blockIdx.x * 8 + wave, NGW = gridDim.x * 8;
    const float* ssq = (const float*)(a.ws + WS_SSQ) + 2 * MTOK;
    const bf16_t* HB = (const bf16_t*)(a.ws + WS_HB0);
    const f32x4* fg = (const f32x4*)a.in[I_FNG] + 2 * lane;
    for (int mrow = gw; mrow < MTOK; mrow += NGW) {
        const float rs = __builtin_amdgcn_rsqf(ssq[mrow] * (1.0f / DM) + RMS_EPS);
        const u32x4* hr = (const u32x4*)(HB + (size_t)mrow * DM) + lane; f32x4* orow = (f32x4*)(a.out + (size_t)mrow * DM) + 2 * lane;
        u32x4 hv[4];
#pragma unroll
        for (int j = 0; j < 4; ++j) hv[j] = hr[64 * j];
        asm volatile("" ::: "memory");
#pragma unroll
        for (int j = 0; j < 4; ++j) { f32x4 h0, h1; unpack8(hv[j], h0, h1); orow[128 * j] = h0 * rs * fg[128 * j]; orow[128 * j + 1] = h1 * rs * fg[128 * j + 1]; }
    }
}

#define XB_TMO      128
#define XB_XCNT(j)  (256  + 64 * (j))
#define XB_XSUB(j)  (1280 + 64 * (j))
#define XB_XGEN(j)  (2304 + 64 * (j))
#define XB_TOP      3328
#define XB_TOPGEN   3392
#define XCD_BAR_WORDS 3456
#define XB_SPIN_CAP (1u << 20)
__device__ __forceinline__ unsigned xb_ld(unsigned* p)              { return __hip_atomic_load(p, __ATOMIC_RELAXED, __HIP_MEMORY_SCOPE_AGENT); }
__device__ __forceinline__ unsigned xb_add(unsigned* p, unsigned v) { return __hip_atomic_fetch_add(p, v, __ATOMIC_RELAXED, __HIP_MEMORY_SCOPE_AGENT); }
__device__ __forceinline__ unsigned xb_xcc_id() { return (unsigned)__builtin_amdgcn_s_getreg((3 << 11) | 20) & 0xFu; }
#define XB_SPIN(cond, bar) do { unsigned _sp = 0; while (cond) { __builtin_amdgcn_s_sleep(1); \
    if ((++_sp & 255u) == 0u) { if (xb_ld(&(bar)[XB_TMO])) break; if (_sp > XB_SPIN_CAP) { atomicAdd(&(bar)[XB_TMO], 1u); break; } } } } while (0)
struct XcdBarrier { unsigned* bar; unsigned x; volatile LAS unsigned* st; };
__device__ __forceinline__ XcdBarrier xcd_barrier_post(unsigned* bar, volatile LAS unsigned* st) {
    XcdBarrier b; b.bar = bar; b.x = xb_xcc_id(); b.st = st;
    if (threadIdx.x == 0) st[2] = xb_add(&bar[XB_XCNT(b.x)], 1u);
    return b;
}
__device__ __forceinline__ void xcd_barrier_complete(unsigned* bar, unsigned x, unsigned& nloc, unsigned& nx) {
    const unsigned G = gridDim.x * gridDim.y * gridDim.z;
    unsigned sum, cnt, mine, sp = 0u;
    for (;;) {
        sum = 0u; cnt = 0u; mine = 0u;
#pragma unroll
        for (unsigned j = 0; j < 16; ++j) { const unsigned c = xb_ld(&bar[XB_XCNT(j)]); sum += c; cnt += (c > 0u) ? 1u : 0u; mine = (j == x) ? c : mine; }
        if (sum == G) break;
        __builtin_amdgcn_s_sleep(1);
        if ((++sp & 255u) == 0u) { if (xb_ld(&bar[XB_TMO])) break; if (sp > XB_SPIN_CAP) { atomicAdd(&bar[XB_TMO], 1u); break; } }
    }
    nloc = mine > 0u ? mine : 1u; nx = cnt > 0u ? cnt : 1u;
}
__device__ __forceinline__ void xcd_barrier(const XcdBarrier& b, bool local = false) {
    asm volatile("s_waitcnt vmcnt(0)" ::: "memory");
    __syncthreads();
    if (threadIdx.x == 0) {
        unsigned* bar = b.bar;
        __builtin_amdgcn_s_waitcnt(0);
        unsigned nloc = b.st[0], nx = b.st[1];
        if (nloc == 0u) { xcd_barrier_complete(bar, b.x, nloc, nx); b.st[0] = nloc; b.st[1] = nx; }
        const unsigned old = xb_add(&bar[XB_XSUB(b.x)], 1u);
        const unsigned gen = old / nloc;
        if (old + 1u == (gen + 1u) * nloc) {
            if (!local) {
            __builtin_amdgcn_fence(__ATOMIC_RELEASE, "agent");
            asm volatile("s_waitcnt vmcnt(0)" ::: "memory");
            const unsigned og = xb_add(&bar[XB_TOP], 1u);
            const unsigned tg = og / nx;
            if (og + 1u == (tg + 1u) * nx) xb_add(&bar[XB_TOPGEN], 1u);
            else XB_SPIN(xb_ld(&bar[XB_TOPGEN]) == tg, bar);
            }
            __builtin_amdgcn_fence(__ATOMIC_ACQUIRE, "agent");
            xb_add(&bar[XB_XGEN(b.x)], 1u);
            asm volatile("s_waitcnt vmcnt(0)" ::: "memory");
        } else {
            XB_SPIN(xb_ld(&bar[XB_XGEN(b.x)]) == gen, bar);
            __builtin_amdgcn_fence(__ATOMIC_ACQUIRE, "agent");
            asm volatile("s_waitcnt vmcnt(0)" ::: "memory");
        }
    }
    __syncthreads();
}

__global__ void __launch_bounds__(512, 2) fwd_megakernel(Args a) {
    extern __shared__ __attribute__((aligned(16))) unsigned char lds_raw[];
    LAS unsigned char* lds = (LAS unsigned char*)lds_raw;
    cg::grid_group grid = cg::this_grid();
    unsigned char* ws = a.ws;
    const int lo = a.ph_lo, hi = a.ph_hi;
#ifndef PH_MASK
#define PH_MASK 0xffff
#endif
#define KIND(b) ((PH_MASK >> (b)) & 1)
#define IN(k) (lo <= (k) && (k) < hi)
#define SEAM(k) do { if (IN(k) && IN((k) + 1)) { if (lo < 0) grid.sync(); else xcd_barrier(xb); } } while (0)
#define SEAML(k) do { if (IN(k) && IN((k) + 1)) xcd_barrier(xb, lx >= 0); } while (0)
    volatile LAS unsigned* xst = (volatile LAS unsigned*)(lds + LDS_BYTES - 16);
    if (threadIdx.x < 4) xst[threadIdx.x] = 0u;
    __syncthreads();
    XcdBarrier xb = xcd_barrier_post((unsigned*)(ws + WS_BAR), xst);
    float* ssq = (float*)(ws + WS_SSQ);
    bf16_t* hb0 = (bf16_t*)(ws + WS_HB0); bf16_t* hb1 = (bf16_t*)(ws + WS_HB1);
    bf16_t* PROJ = (bf16_t*)(ws + WS_PROJ); bf16_t* Y = (bf16_t*)(ws + WS_Y); bf16_t* MG = (bf16_t*)(ws + WS_MG);

    if (IN(0) && KIND(0)) { p0_prologue(a, lds); __syncthreads(); }
    SEAM(0);
    int lx = -1, lr = 0;
    if (IN(0) && IN(1) && gridDim.x == 256u && xb.x < 8u) {
        unsigned* bar = (unsigned*)(ws + WS_BAR); bool even = true;
#pragma unroll
        for (unsigned j = 0; j < 16; ++j) { const unsigned cj = xb_ld(&bar[XB_XCNT(j)]); even = even && (cj == (j < 8u ? 32u : 0u)); }
        const unsigned rank = xst[2];
        if (even && rank < 32u) { lx = (int)xb.x; lr = (int)rank; }
    }
    lx = __builtin_amdgcn_readfirstlane(lx); lr = __builtin_amdgcn_readfirstlane(lr);
    for (int l = 0; l < DEPTH; ++l) {
        const int pb = 1 + 6 * l;
        if (IN(pb) && KIND(2)) {
            constexpr int TFULL = NC / 256 - 4;
            { pg8::Gemm g{hb0, (const bf16_t*)(ws + WS_WI + l * SZ_WI), DM, DM, DM, MTOK / 256, TFULL, 0, lx, lr};
              EpiProj E{PROJ, ssq + l * MTOK, 0};
              pg8::gemm_phase<EpiProj>(lds, g, E); }
            { pg8::Gemm g{hb0, (const bf16_t*)(ws + WS_WI + l * SZ_WI) + (size_t)TFULL * 256 * DM, DM, DM, DM, MTOK / 256, 4, 0, lx, lr};
              EpiProj E{PROJ, ssq + l * MTOK, TFULL};
              pg8::gemm_phase<EpiProj, pg8::HalfNOrder, true>(lds, g, E); }
        }
        SEAM(pb);
        if (IN(pb + 1) && KIND(3)) {
            if (lx >= 0) mixer_phase(a, l, lds, lx * (MTOK / TT / 8) + lr, 32, (lx + 1) * (MTOK / TT / 8));
            else mixer_phase(a, l, lds, (int)blockIdx.x, (int)gridDim.x, MTOK / TT);
            __syncthreads(); }
        SEAML(pb + 1);
        if (IN(pb + 2) && KIND(4)) {
            pg8::Gemm g{(const bf16_t*)(ws + WS_POOL), (const bf16_t*)(ws + WS_PW + l * SZ_PW), EW, 256, 256, MTOK / 256, 4, 256, lx, lr};
            EpiPool E{Y, a.in[I_PS] + (size_t)l * EW, PROJ};
            pg8::gemm_phase<EpiPool>(lds, g, E);
            if (KIND(1)) {
                pg8::Gemm gq{(const bf16_t*)(ws + WS_PB + l * SZ_PB), (const bf16_t*)(ws + WS_WP + l * SZ_WP), PD, PD, PD, MTOK / 256, DM / 256, 0, lx, lr};
                EpiPlain Eq{(bf16_t*)(ws + WS_PLE + l * SZ_ACT), DM};
                pg8::gemm_phase<EpiPlain, pg8::IdleOrder>(lds, gq, Eq);
            }
        }
        SEAML(pb + 2);
        if (IN(pb + 3) && KIND(5)) {
            pg8::Gemm g{Y, (const bf16_t*)(ws + WS_WB + l * SZ_WB), YW, YW, YW, MTOK / 256, DM / 256, 0, lx, lr};
            EpiMerge E{PROJ, MG};
            pg8::gemm_phase<EpiMerge>(lds, g, E);
        }
        SEAML(pb + 3);
        if (IN(pb + 4) && KIND(6)) {
            pg8::Gemm g{MG, (const bf16_t*)(ws + WS_WO + l * SZ_WO), DM, DM, DM, MTOK / 256, DM / 256, 0, lx, lr};
            EpiWo E{(const float*)nullptr, hb0, hb1};
            pg8::gemm_phase<EpiWo>(lds, g, E);
        }
        SEAML(pb + 4);
        if (IN(pb + 5) && KIND(7)) {
            pg8::Gemm g{hb1, (const bf16_t*)(ws + WS_WG + l * SZ_WO), DM, DM, DM, MTOK / 256, DM / 256, 0, lx, lr};
            EpiGate E{hb1, (const bf16_t*)(ws + WS_PLE + l * SZ_ACT), hb0, ssq + (l + 1) * MTOK};
            pg8::gemm_phase<EpiGate>(lds, g, E);
        }
        SEAM(pb + 5);
    }
    if (IN(13) && KIND(8)) final_phase(a);
#undef IN
#undef SEAM
}

#ifndef MK_NLAUNCH
#define MK_NLAUNCH 1
#endif
extern "C" void kernel_launch(void* const* d_in, const int* in_sizes, int n_in, void* d_out, int out_size, void* d_ws, size_t ws_size, hipStream_t stream) {
    static int grid = 0;
    if (grid == 0) {
        if (n_in != 16 || ws_size < WS_END) { fprintf(stderr, "kernel_launch: expected 16 inputs and >= %zu bytes of workspace (got %d, %zu)\n", (size_t)WS_END, n_in, ws_size); grid = -1; return; }
        int dev = 0, cus = 0, per_cu = 0;
        hipGetDevice(&dev);
        hipDeviceGetAttribute(&cus, hipDeviceAttributeMultiprocessorCount, dev);
        if (hipFuncSetAttribute((const void*)fwd_megakernel, hipFuncAttributeMaxDynamicSharedMemorySize, LDS_BYTES) != hipSuccess) { fprintf(stderr, "kernel_launch: hipFuncSetAttribute failed\n"); grid = -1; return; }
        if (hipOccupancyMaxActiveBlocksPerMultiprocessor(&per_cu, (const void*)fwd_megakernel, 512, LDS_BYTES) != hipSuccess || per_cu < 1) { fprintf(stderr, "kernel_launch: occupancy query says %d\n", per_cu); per_cu = 1; }
        (void)hipGetLastError();
        grid = cus * 1;
        fprintf(stderr, "kernel_launch: grid %d (cus %d, per_cu %d)\n", grid, cus, per_cu);
    }
    if (grid < 0) return;
    if (hipMemsetAsync((char*)d_ws + WS_BAR, 0, XCD_BAR_WORDS * 4, stream) != hipSuccess) { fprintf(stderr, "kernel_launch: memset of the barrier words failed\n"); return; }
    Args a{};
    for (int i = 0; i < 16; ++i) a.in[i] = (const float*)d_in[i];
    a.out = (float*)d_out; a.ws = (unsigned char*)d_ws;
#if MK_NLAUNCH == 1
    a.ph_lo = 0; a.ph_hi = 14;
    { void* args[] = {&a}; hipError_t e = hipLaunchCooperativeKernel((const void*)fwd_megakernel, dim3(grid), dim3(512), args, LDS_BYTES, stream);
      if (e != hipSuccess) fprintf(stderr, "cooperative launch failed: %s (grid %d)\n", hipGetErrorString(e), grid); }
#else
    for (int ph = 0; ph < 14; ++ph) { a.ph_lo = ph; a.ph_hi = ph + 1; void* args[] = {&a};
        hipError_t e = hipLaunchCooperativeKernel((const void*)fwd_megakernel, dim3(grid), dim3(512), args, LDS_BYTES, stream);
        if (e != hipSuccess) { fprintf(stderr, "launch %d failed: %s\n", ph, hipGetErrorString(e)); break; } }
#endif
}
```
